# Optimizing an MI355X kernel written in HIP

```python
import math
import jax
import jax.numpy as jnp
from jax import lax
import numpy as np

D_MODEL = 1024
BATCH = 16
SEQ = 2048
DEPTH = 1

CTX_LEN = 256
GRID_W = 64
D_MIX = D_MODEL
D_S5 = D_MIX // 2
S5_GROUP = 16
S5_GROUPS = D_S5 // S5_GROUP
S5_STATE = 64
D_GDN = D_MIX - D_S5
GDN_HEAD = 128
GDN_HEADS = D_GDN // GDN_HEAD
CHUNK = 64
CONV_K = 3
N_DIR = 2
P_IN = 2 * D_S5 + 4 * D_GDN + 2 * N_DIR * GDN_HEADS
DEEPNORM_ALPHA = (2.0 * DEPTH) ** 0.25
DEEPNORM_BETA = (8.0 * DEPTH) ** -0.25
LN_EPS = 1e-5
NORM_EPS = 1e-6

kernel_name = "hybrid_s5_gdn_prefix_dit_block"


def _proj_splits():
    widths = (D_S5, D_S5, 3 * D_GDN, D_GDN, N_DIR * GDN_HEADS, N_DIR * GDN_HEADS)
    return tuple(int(v) for v in np.cumsum(widths)[:-1])


def _layer_norm(x, g, b):
    xf = x.astype(jnp.float32)
    mu = jnp.mean(xf, -1, keepdims=True)
    var = jnp.mean(jnp.square(xf - mu), -1, keepdims=True)
    return ((xf - mu) * lax.rsqrt(var + LN_EPS) * g.astype(jnp.float32) + b.astype(jnp.float32)).astype(x.dtype)


def _ada(cond, w_ada, b_ada):
    m = jax.nn.silu(cond) @ w_ada + b_ada
    return jnp.split(m, 3, axis=-1)


def _maybe_flip(t, rev):
    return jnp.flip(t, 1) if rev else t


def _s5_zoh(lam_re, lam_im, log_dt, b_re, b_im):
    lam = lax.complex(lam_re.astype(jnp.float32), lam_im.astype(jnp.float32))
    dt = jnp.exp(log_dt.astype(jnp.float32))[:, None]
    abar = jnp.exp(lam * dt)
    bmat = lax.complex(b_re.astype(jnp.float32), b_im.astype(jnp.float32))
    bbar = ((abar - 1.0) / lam)[..., None] * bmat
    return abar, bbar


def _s5_combine(e1, e2):
    a1, b1 = e1
    a2, b2 = e2
    return a1 * a2, a2 * b1 + b2


def _s5_states(u, abar, bbar, h0, rev):
    bu = jnp.einsum('blgc,gpc->blgp', u, bbar)
    bu = _maybe_flip(bu, rev)
    bu = bu.at[:, 0].add(abar * h0)
    a = jnp.broadcast_to(abar, (1,) + bu.shape[1:])
    _, h = lax.associative_scan(_s5_combine, (a, bu), axis=1)
    return _maybe_flip(h, rev), h[:, -1]


def _s5_readout(h, c_re, c_im):
    cmat = lax.complex(c_re.astype(jnp.float32), c_im.astype(jnp.float32))
    y = jnp.real(jnp.einsum('blgp,gcp->blgc', h, cmat))
    return y.reshape(y.shape[0], y.shape[1], D_S5)


def _s5_glu(y, w_glu, b_glu):
    g = jax.nn.gelu(y, approximate=False)
    return g * jax.nn.sigmoid(g @ w_glu.astype(jnp.float32) + b_glu.astype(jnp.float32))


def _s5_mixer(u, uc, z, zc, p, with_ctx):
    B_ = u.shape[0]
    uf = u.astype(jnp.float32)
    ucf = uc.astype(jnp.float32)
    ul = uf.reshape(B_, -1, S5_GROUPS, S5_GROUP)
    ucg = ucf.reshape(B_, -1, S5_GROUPS, S5_GROUP)
    d_skip = p['s5_d'].astype(jnp.float32)
    y_lat = d_skip * uf
    y_ctx = d_skip * ucf if with_ctx else None
    for d in range(N_DIR):
        abar, bbar = _s5_zoh(p['s5_lambda_re'][d], p['s5_lambda_im'][d], p['s5_log_dt'][d],
                             p['s5_b_re'][d], p['s5_b_im'][d])
        h0 = jnp.zeros((B_, S5_GROUPS, S5_STATE), jnp.complex64)
        hs_ctx, h_ctx_end = _s5_states(ucg, abar, bbar, h0, d == 1)
        hs_lat, _ = _s5_states(ul, abar, bbar, h_ctx_end, d == 1)
        y_lat = y_lat + _s5_readout(hs_lat, p['s5_c_re'][d], p['s5_c_im'][d])
        if with_ctx:
            y_ctx = y_ctx + _s5_readout(hs_ctx, p['s5_c_re'][d], p['s5_c_im'][d])
    out_lat = _s5_glu(y_lat, p['w_glu'], p['b_glu']) * jax.nn.silu(z.astype(jnp.float32))
    out_ctx = None
    if with_ctx:
        out_ctx = _s5_glu(y_ctx, p['w_glu'], p['b_glu']) * jax.nn.silu(zc.astype(jnp.float32))
    return out_lat, out_ctx


def _conv_latent(t, w):
    B_, L, C = t.shape
    rows = L // GRID_W
    img = t.reshape(B_, rows, GRID_W, C)
    out = lax.conv_general_dilated(img, w[:, :, None, :].astype(t.dtype), (1, 1), 'SAME',
                                   dimension_numbers=('NHWC', 'HWIO', 'NHWC'), feature_group_count=C)
    return out.reshape(B_, L, C)


def _conv_context(t, w):
    C = t.shape[-1]
    return lax.conv_general_dilated(t, w[CONV_K // 2][:, None, :].astype(t.dtype), (1,), 'SAME',
                                    dimension_numbers=('NWC', 'WIO', 'NWC'), feature_group_count=C)


def _l2norm(t):
    return t * lax.rsqrt(jnp.sum(jnp.square(t), -1, keepdims=True) + NORM_EPS)


def _gdn_qkv_heads(qkv):
    B_, L, _ = qkv.shape
    q, k, v = jnp.split(qkv.astype(jnp.float32), 3, axis=-1)
    q = _l2norm(q.reshape(B_, L, GDN_HEADS, GDN_HEAD)) * (GDN_HEAD ** -0.5)
    k = _l2norm(k.reshape(B_, L, GDN_HEADS, GDN_HEAD))
    v = v.reshape(B_, L, GDN_HEADS, GDN_HEAD)
    return q, k, v


def _gdn_gates(beta_logit, alpha_logit, a_log, dt_bias):
    B_, L, _ = beta_logit.shape
    beta = jax.nn.sigmoid(beta_logit.astype(jnp.float32)).reshape(B_, L, N_DIR, GDN_HEADS)
    a = alpha_logit.astype(jnp.float32).reshape(B_, L, N_DIR, GDN_HEADS)
    g = -jnp.exp(a_log.astype(jnp.float32)) * jax.nn.softplus(a + dt_bias.astype(jnp.float32))
    return beta, g


def _gdn_chunked(q, k, v, beta, g, s0):
    B_, L, H, _ = q.shape
    Dv = v.shape[-1]
    N = L // CHUNK

    def chunk(t):
        return t.reshape(B_, N, CHUNK, H, -1).transpose(1, 0, 3, 2, 4)

    qc, kc, vc = chunk(q), chunk(k), chunk(v)
    bc = chunk(beta[..., None])[..., 0]
    gcum = jnp.cumsum(chunk(g[..., None])[..., 0], axis=-1)
    idx = jnp.arange(CHUNK)
    lower = idx[:, None] >= idx[None, :]
    strict = idx[:, None] > idx[None, :]
    decay = jnp.exp(jnp.where(lower, gcum[..., :, None] - gcum[..., None, :], -jnp.inf))
    kk = jnp.einsum('nbhik,nbhjk->nbhij', kc, kc)
    a_mat = jnp.where(strict, bc[..., :, None] * kk * decay, 0.0)
    gamma = jnp.exp(gcum)
    rhs = jnp.concatenate([bc[..., None] * vc, (bc * gamma)[..., None] * kc], axis=-1)
    eye = jnp.eye(CHUNK, dtype=jnp.float32)
    sol = lax.linalg.triangular_solve(a_mat + eye, rhs, left_side=True, lower=True, unit_diagonal=True)
    u0, w = sol[..., :Dv], sol[..., Dv:]
    qk = jnp.einsum('nbhik,nbhjk->nbhij', qc, kc) * decay
    k_out = kc * jnp.exp(gcum[..., -1:] - gcum)[..., None]
    gamma_last = gamma[..., -1]

    def step(s, inp):
        qi, ki, ui0, wi, qki, gi, gli = inp
        u = ui0 - jnp.einsum('bhck,bhkv->bhcv', wi, s)
        o = gi[..., None] * jnp.einsum('bhck,bhkv->bhcv', qi, s) + jnp.einsum('bhij,bhjv->bhiv', qki, u)
        s = gli[..., None, None] * s + jnp.einsum('bhck,bhcv->bhkv', ki, u)
        return s, o

    s_fin, o = lax.scan(step, s0, (qc, k_out, u0, w, qk, gamma, gamma_last))
    o = o.transpose(1, 0, 3, 2, 4).reshape(B_, L, H, Dv)
    return o, s_fin


def _gated_rmsnorm(o, z, w):
    o = o * lax.rsqrt(jnp.mean(jnp.square(o), -1, keepdims=True) + NORM_EPS) * w.astype(jnp.float32)
    return o.reshape(z.shape) * jax.nn.silu(z.astype(jnp.float32))


def _gdn_mixer(qkv, qkvc, z, zc, beta_l, beta_c, alpha_l, alpha_c, p, with_ctx):
    qkv = jax.nn.silu(_conv_latent(qkv, p['conv_w']))
    qkvc = jax.nn.silu(_conv_context(qkvc, p['conv_w']))
    ql, kl, vl = _gdn_qkv_heads(qkv)
    qc, kc, vc = _gdn_qkv_heads(qkvc)
    bl, gl = _gdn_gates(beta_l, alpha_l, p['gdn_a_log'], p['gdn_dt_bias'])
    bcx, gcx = _gdn_gates(beta_c, alpha_c, p['gdn_a_log'], p['gdn_dt_bias'])
    B_ = ql.shape[0]
    o_lat = jnp.zeros(vl.shape, jnp.float32)
    o_ctx = jnp.zeros(vc.shape, jnp.float32)
    for d in range(N_DIR):
        rev = d == 1
        f = lambda t: _maybe_flip(t, rev)
        s0 = jnp.zeros((B_, GDN_HEADS, GDN_HEAD, GDN_HEAD), jnp.float32)
        oc, s_ctx = _gdn_chunked(f(qc), f(kc), f(vc), f(bcx[:, :, d]), f(gcx[:, :, d]), s0)
        ol, _ = _gdn_chunked(f(ql), f(kl), f(vl), f(bl[:, :, d]), f(gl[:, :, d]), s_ctx)
        o_lat = o_lat + f(ol)
        o_ctx = o_ctx + f(oc)
    out_lat = _gated_rmsnorm(o_lat, z, p['gdn_norm_w'])
    out_ctx = _gated_rmsnorm(o_ctx, zc, p['gdn_norm_w']) if with_ctx else None
    return out_lat, out_ctx


def _layer(x, ctx, c, c_ctx, p, with_ctx):
    shift, scale, gate = _ada(c, p['w_ada'], p['b_ada'])
    shift_c, scale_c, gate_c = _ada(c_ctx, p['w_ada'], p['b_ada'])
    h = x * (1.0 + scale[:, None]) + shift[:, None]
    hc = ctx * (1.0 + scale_c) + shift_c
    u, z_s5, qkv, z_gdn, beta_l, alpha_l = jnp.split(h @ p['w_in'], _proj_splits(), axis=-1)
    uc, z_s5c, qkvc, z_gdnc, beta_c, alpha_c = jnp.split(hc @ p['w_in'], _proj_splits(), axis=-1)
    s5_lat, s5_ctx = _s5_mixer(u, uc, z_s5, z_s5c, p, with_ctx)
    gdn_lat, gdn_ctx = _gdn_mixer(qkv, qkvc, z_gdn, z_gdnc, beta_l, beta_c, alpha_l, alpha_c, p, with_ctx)
    w_out = p['w_out'].astype(jnp.float32)
    y = jnp.concatenate([s5_lat, gdn_lat], axis=-1) @ w_out
    x_new = _layer_norm(DEEPNORM_ALPHA * x + gate[:, None] * y.astype(x.dtype), p['ln_g'], p['ln_b'])
    if not with_ctx:
        return x_new, ctx
    yc = jnp.concatenate([s5_ctx, gdn_ctx], axis=-1) @ w_out
    ctx_new = _layer_norm(DEEPNORM_ALPHA * ctx + gate_c * yc.astype(ctx.dtype), p['ln_g'], p['ln_b'])
    return x_new, ctx_new


def setup_inputs(seed: int = 0) -> dict:
    key = jax.random.key(seed)
    ks = jax.random.split(key, 24)
    f32 = jnp.float32

    def nrm(k, shape, s):
        return jax.random.normal(k, shape, f32) * s

    lam_shape = (DEPTH, N_DIR, S5_GROUPS, S5_STATE)
    n = jnp.arange(S5_STATE, dtype=f32)
    dt = jnp.exp(jax.random.uniform(ks[19], (DEPTH, N_DIR, GDN_HEADS), f32, math.log(1e-3), math.log(1e-1)))
    return {
        "x": nrm(ks[0], (BATCH, SEQ, D_MODEL), 1.0),
        "c": nrm(ks[1], (BATCH, D_MODEL), 1.0),
        "ctx": nrm(ks[2], (BATCH, CTX_LEN, D_MODEL), 1.0),
        "c_ctx": nrm(ks[3], (D_MODEL,), 1.0),
        "w_ada": nrm(ks[4], (DEPTH, D_MODEL, 3 * D_MODEL), 0.5 * D_MODEL ** -0.5),
        "b_ada": nrm(ks[5], (DEPTH, 3 * D_MODEL), 0.01),
        "w_in": nrm(ks[6], (DEPTH, D_MODEL, P_IN), D_MODEL ** -0.5),
        "s5_lambda_re": -0.5 + nrm(ks[7], lam_shape, 0.01),
        "s5_lambda_im": math.pi * n + nrm(ks[8], lam_shape, 0.01),
        "s5_log_dt": jax.random.uniform(ks[9], (DEPTH, N_DIR, S5_GROUPS), f32, math.log(1e-3), math.log(1e-1)),
        "s5_b_re": nrm(ks[10], (DEPTH, N_DIR, S5_GROUPS, S5_STATE, S5_GROUP), (2 * S5_GROUP) ** -0.5),
        "s5_b_im": nrm(ks[11], (DEPTH, N_DIR, S5_GROUPS, S5_STATE, S5_GROUP), (2 * S5_GROUP) ** -0.5),
        "s5_c_re": nrm(ks[12], (DEPTH, N_DIR, S5_GROUPS, S5_GROUP, S5_STATE), (2 * S5_STATE) ** -0.5),
        "s5_c_im": nrm(ks[13], (DEPTH, N_DIR, S5_GROUPS, S5_GROUP, S5_STATE), (2 * S5_STATE) ** -0.5),
        "s5_d": nrm(ks[14], (DEPTH, D_S5), 1.0),
        "w_glu": nrm(ks[15], (DEPTH, D_S5, D_S5), D_S5 ** -0.5),
        "b_glu": nrm(ks[16], (DEPTH, D_S5), 0.01),
        "conv_w": nrm(ks[17], (DEPTH, CONV_K, CONV_K, 3 * D_GDN), 1.0 / CONV_K),
        "gdn_a_log": jnp.log(jax.random.uniform(ks[18], (DEPTH, N_DIR, GDN_HEADS), f32, 1.0, 16.0)),
        "gdn_dt_bias": dt + jnp.log(-jnp.expm1(-dt)),
        "gdn_norm_w": 1.0 + nrm(ks[20], (DEPTH, GDN_HEAD), 0.01),
        "w_out": nrm(ks[21], (DEPTH, D_MIX, D_MODEL), DEEPNORM_BETA * D_MIX ** -0.5),
        "ln_g": 1.0 + nrm(ks[22], (DEPTH, D_MODEL), 0.01),
        "ln_b": nrm(ks[23], (DEPTH, D_MODEL), 0.01),
    }


def reference(x, c, ctx, c_ctx, w_ada, b_ada, w_in, s5_lambda_re, s5_lambda_im, s5_log_dt,
              s5_b_re, s5_b_im, s5_c_re, s5_c_im, s5_d, w_glu, b_glu, conv_w, gdn_a_log,
              gdn_dt_bias, gdn_norm_w, w_out, ln_g, ln_b):
    for l in range(DEPTH):
        p = {
            'w_ada': w_ada[l], 'b_ada': b_ada[l], 'w_in': w_in[l],
            's5_lambda_re': s5_lambda_re[l], 's5_lambda_im': s5_lambda_im[l], 's5_log_dt': s5_log_dt[l],
            's5_b_re': s5_b_re[l], 's5_b_im': s5_b_im[l], 's5_c_re': s5_c_re[l], 's5_c_im': s5_c_im[l],
            's5_d': s5_d[l], 'w_glu': w_glu[l], 'b_glu': b_glu[l], 'conv_w': conv_w[l],
            'gdn_a_log': gdn_a_log[l], 'gdn_dt_bias': gdn_dt_bias[l], 'gdn_norm_w': gdn_norm_w[l],
            'w_out': w_out[l], 'ln_g': ln_g[l], 'ln_b': ln_b[l],
        }
        x, ctx = _layer(x, ctx, c, c_ctx, p, l < DEPTH - 1)
    return x
```

```cpp
#include <hip/hip_runtime.h>
#include <hip/hip_cooperative_groups.h>
#include <cstdio>
#include <cstdint>
namespace cg = cooperative_groups;

#ifndef MK_ONE_LAUNCH
#define MK_ONE_LAUNCH 1
#endif

typedef _Float16 h16;
typedef _Float16 h16x4 __attribute__((ext_vector_type(4)));
typedef _Float16 h16x8 __attribute__((ext_vector_type(8)));
typedef float f32x4 __attribute__((ext_vector_type(4)));
#define DI __device__ __forceinline__

constexpr int DM = 1024, NB = 16, SEQ = 2048, CTXL = 256, TPB = CTXL + SEQ  ;
constexpr int NT = NB * TPB  , NL = NB * SEQ  ;
constexpr int PIN = 3088;
constexpr int NTHR = 512;
constexpr float DN_ALPHA = 1.189207115002721f;

constexpr size_t MiB = 1u << 20;
constexpr size_t WS_CTL = 0, WS_ADA = 1 * MiB;
constexpr size_t WS_UG = 32 * MiB, WS_ZS = 68 * MiB, WS_QKV = 104 * MiB, WS_ZG = 212 * MiB, WS_GL = 248 * MiB;
constexpr size_t WS_QC = 252 * MiB, WS_KC = 288 * MiB, WS_VC = 324 * MiB, WS_BETA = 360 * MiB, WS_GDEC = 362 * MiB;
constexpr size_t WS_YS5 = 364 * MiB, WS_G = 428 * MiB, WS_MIX = 104 * MiB, WS_Y = 364 * MiB, WS_END = 512 * MiB;

struct Params {
    const float *x, *c, *ctx, *c_ctx, *w_ada, *b_ada, *w_in, *lre, *lim, *logdt, *bre, *bim, *cre, *cim, *s5d,
        *w_glu, *b_glu, *conv_w, *a_log, *dt_bias, *norm_w, *w_out, *ln_g, *ln_b;
    float* out;
    unsigned char* ws;
};

DI float silu_f(float v) { return v / (1.f + __expf(-v)); }
DI float sigmoid_f(float v) { return 1.f / (1.f + __expf(-v)); }
DI float gelu_f(float v) { return 0.5f * v * (1.f + erff(v * 0.70710678118654752f)); }
DI float softplus_f(float v) { return v > 20.f ? v : log1pf(expf(v)); }

DI void phase_ada(const Params& p, float* lds) {
    const int tid = threadIdx.x;
    if ((int)blockIdx.x >= 48) return;
    float* sc = lds;
    float* red = lds + 17 * 1024;
    float* ADA = (float*)(p.ws + WS_ADA);
    for (int i = tid; i < 17 * 1024; i += NTHR) {
        const int r = i >> 10, k = i & 1023;
        const float v = r < 16 ? p.c[r * 1024 + k] : p.c_ctx[k];
        sc[i] = silu_f(v);
    }
    __syncthreads();
    for (int unit = blockIdx.x; unit < 48; unit += gridDim.x) {
        const int ks = tid >> 6, col = tid & 63, n = unit * 64 + col;
        float acc[17];
#pragma unroll
        for (int r = 0; r < 17; ++r) acc[r] = 0.f;
        for (int k = ks * 128; k < ks * 128 + 128; ++k) {
            const float w = p.w_ada[(size_t)k * 3072 + n];
#pragma unroll
            for (int r = 0; r < 17; ++r) acc[r] += sc[r * 1024 + k] * w;
        }
#pragma unroll
        for (int r = 0; r < 17; ++r) red[(ks * 17 + r) * 64 + col] = acc[r];
        __syncthreads();
        for (int i = tid; i < 17 * 64; i += NTHR) {
            const int r = i >> 6, cc = i & 63;
            float s = p.b_ada[unit * 64 + cc];
#pragma unroll
            for (int q = 0; q < 8; ++q) s += red[(q * 17 + r) * 64 + cc];
            ADA[r * 3072 + unit * 64 + cc] = s;
        }
        __syncthreads();
    }
}

template <class AL, class BL, class EP>
DI void gemm_naive(int N, int K, int ntm, int ntn, const AL& al, const BL& bl, const EP& ep, float* lds) {
    const int tid = threadIdx.x, ty = tid >> 5, tx = tid & 31;
    float* As = lds;
    float* Bs = lds + 16 * 132;
    for (int tile = blockIdx.x; tile < ntm * ntn; tile += gridDim.x) {
        const int tm = tile / ntn, tn = tile % ntn;
        f32x4 acc[8];
#pragma unroll
        for (int i = 0; i < 8; ++i) acc[i] = (f32x4){0.f, 0.f, 0.f, 0.f};
        const int arow = tm * 128 + (tid >> 2), akk = (tid & 3) * 4;
        const int bk = tid >> 5, bcol = tn * 128 + (tid & 31) * 4;
#pragma unroll 1
        for (int k0 = 0; k0 < K; k0 += 16) {
            const f32x4 a = al(arow, k0 + akk);
            f32x4 b = (f32x4){0.f, 0.f, 0.f, 0.f};
            if (bcol < N) b = bl(k0 + bk, bcol);
            __syncthreads();
#pragma unroll
            for (int j = 0; j < 4; ++j) As[(akk + j) * 132 + (tid >> 2)] = a[j];
            *(f32x4*)(Bs + bk * 128 + (tid & 31) * 4) = b;
            __syncthreads();
#pragma unroll
            for (int k = 0; k < 16; ++k) {
                const f32x4 a0 = *(const f32x4*)(As + k * 132 + ty * 8), a1 = *(const f32x4*)(As + k * 132 + ty * 8 + 4);
                const f32x4 bv = *(const f32x4*)(Bs + k * 128 + tx * 4);
                acc[0] += bv * a0[0]; acc[1] += bv * a0[1]; acc[2] += bv * a0[2]; acc[3] += bv * a0[3];
                acc[4] += bv * a1[0]; acc[5] += bv * a1[1]; acc[6] += bv * a1[2]; acc[7] += bv * a1[3];
            }
        }
        ep(tm * 128 + ty * 8, tn * 128 + tx * 4, acc);
    }
}

struct BLoadF32 {
    const float* w; int N;
    DI f32x4 operator()(int k, int col) const { return *(const f32x4*)(w + (size_t)k * N + col); }
};
struct ALoadF16 {
    const h16* a; int lda;
    DI f32x4 operator()(int row, int k) const {
        const h16x4 v = *(const h16x4*)(a + (size_t)row * lda + k);
        return (f32x4){(float)v[0], (float)v[1], (float)v[2], (float)v[3]};
    }
};
struct ALoadInproj {
    const float *x, *ctx, *ADA;
    DI f32x4 operator()(int row, int k) const {
        const int b = row / TPB, t = row % TPB;
        const float* src = t < CTXL ? ctx + ((size_t)b * CTXL + t) * DM : x + ((size_t)b * SEQ + (t - CTXL)) * DM;
        const int cr = t < CTXL ? 16 : b;
        const f32x4 v = *(const f32x4*)(src + k);
        const f32x4 sh = *(const f32x4*)(ADA + cr * 3072 + k), sc = *(const f32x4*)(ADA + cr * 3072 + 1024 + k);
        return v * (sc + 1.0f) + sh;
    }
};
DI h16x4 to_h4(const f32x4 a) { return (h16x4){(h16)a[0], (h16)a[1], (h16)a[2], (h16)a[3]}; }
struct EpiInproj {
    h16 *UG, *ZS, *QKV, *ZG; float* GL;
    DI void operator()(int r0, int c0, const f32x4 (&acc)[8]) const {
        if (c0 >= PIN) return;
#pragma unroll
        for (int i = 0; i < 8; ++i) {
            const int row = r0 + i, b = row / TPB, t = row % TPB;
            if (c0 < 512) *(h16x4*)(UG + (((size_t)b * 32 + (c0 >> 4)) * TPB + t) * 16 + (c0 & 15)) = to_h4(acc[i]);
            else if (c0 < 1024) *(h16x4*)(ZS + (size_t)row * 512 + (c0 - 512)) = to_h4(acc[i]);
            else if (c0 < 2560) *(h16x4*)(QKV + (size_t)row * 1536 + (c0 - 1024)) = to_h4(acc[i]);
            else if (c0 < 3072) *(h16x4*)(ZG + (size_t)row * 512 + (c0 - 2560)) = to_h4(acc[i]);
            else *(f32x4*)(GL + (size_t)row * 16 + (c0 - 3072)) = acc[i];
        }
    }
};
struct EpiGlu {
    const h16 *G, *ZS; const float* b_glu; h16* MIX;
    DI void operator()(int r0, int c0, const f32x4 (&acc)[8]) const {
#pragma unroll
        for (int i = 0; i < 8; ++i) {
            const int r = r0 + i, b = r / SEQ, tl = r % SEQ;
            const size_t rnt = (size_t)b * TPB + CTXL + tl;
            const h16x4 g = *(const h16x4*)(G + (size_t)r * 512 + c0), z = *(const h16x4*)(ZS + rnt * 512 + c0);
            f32x4 o;
#pragma unroll
            for (int j = 0; j < 4; ++j) o[j] = (float)g[j] * sigmoid_f(acc[i][j] + b_glu[c0 + j]) * silu_f((float)z[j]);
            *(h16x4*)(MIX + (size_t)r * 1024 + c0) = to_h4(o);
        }
    }
};
struct EpiF32Out {
    float* Y; int ldc;
    DI void operator()(int r0, int c0, const f32x4 (&acc)[8]) const {
#pragma unroll
        for (int i = 0; i < 8; ++i) *(f32x4*)(Y + (size_t)(r0 + i) * ldc + c0) = acc[i];
    }
};

DI void phase_inproj(const Params& p, float* lds) {
    ALoadInproj al{p.x, p.ctx, (const float*)(p.ws + WS_ADA)};
    BLoadF32 bl{p.w_in, PIN};
    EpiInproj ep{(h16*)(p.ws + WS_UG), (h16*)(p.ws + WS_ZS), (h16*)(p.ws + WS_QKV), (h16*)(p.ws + WS_ZG), (float*)(p.ws + WS_GL)};
    gemm_naive(PIN, DM, NT / 128, (PIN + 127) / 128, al, bl, ep, lds);
}

DI void phase_gdn_prep(const Params& p) {
    const int lane = threadIdx.x & 63, wave = threadIdx.x >> 6;
    const h16* QKV = (const h16*)(p.ws + WS_QKV);
    const float* GL = (const float*)(p.ws + WS_GL);
    h16* OUT[3] = {(h16*)(p.ws + WS_QC), (h16*)(p.ws + WS_KC), (h16*)(p.ws + WS_VC)};
    float* BETA = (float*)(p.ws + WS_BETA); float* GDEC = (float*)(p.ws + WS_GDEC);
    for (int r = blockIdx.x * 8 + wave; r < NT; r += gridDim.x * 8) {
        const int b = r / TPB, t = r % TPB;
        float acc[3][8];
#pragma unroll
        for (int s = 0; s < 3; ++s)
#pragma unroll
            for (int j = 0; j < 8; ++j) acc[s][j] = 0.f;
        if (t < CTXL) {
            for (int kx = 0; kx < 3; ++kx) {
                const int tt = t + kx - 1;
                if (tt < 0 || tt >= CTXL) continue;
                const size_t rr = (size_t)b * TPB + tt;
#pragma unroll
                for (int s = 0; s < 3; ++s) {
                    const h16x8 v = *(const h16x8*)(QKV + rr * 1536 + s * 512 + lane * 8);
                    const float* w = p.conv_w + (1 * 3 + kx) * 1536 + s * 512 + lane * 8;
#pragma unroll
                    for (int j = 0; j < 8; ++j) acc[s][j] += (float)v[j] * w[j];
                }
            }
        } else {
            const int tl = t - CTXL, gy = tl >> 6, gx = tl & 63;
            for (int ky = 0; ky < 3; ++ky) {
                const int yy = gy + ky - 1;
                if (yy < 0 || yy >= 32) continue;
                for (int kx = 0; kx < 3; ++kx) {
                    const int xx = gx + kx - 1;
                    if (xx < 0 || xx >= 64) continue;
                    const size_t rr = (size_t)b * TPB + CTXL + yy * 64 + xx;
#pragma unroll
                    for (int s = 0; s < 3; ++s) {
                        const h16x8 v = *(const h16x8*)(QKV + rr * 1536 + s * 512 + lane * 8);
                        const float* w = p.conv_w + (ky * 3 + kx) * 1536 + s * 512 + lane * 8;
#pragma unroll
                        for (int j = 0; j < 8; ++j) acc[s][j] += (float)v[j] * w[j];
                    }
                }
            }
        }
#pragma unroll
        for (int s = 0; s < 3; ++s)
#pragma unroll
            for (int j = 0; j < 8; ++j) acc[s][j] = silu_f(acc[s][j]);
#pragma unroll
        for (int s = 0; s < 2; ++s) {
            float ss = 0.f;
#pragma unroll
            for (int j = 0; j < 8; ++j) ss += acc[s][j] * acc[s][j];
            ss += __shfl_xor(ss, 1); ss += __shfl_xor(ss, 2); ss += __shfl_xor(ss, 4); ss += __shfl_xor(ss, 8);
            const float sc = rsqrtf(ss + 1e-6f) * (s == 0 ? 0.08838834764831845f : 1.0f);
#pragma unroll
            for (int j = 0; j < 8; ++j) acc[s][j] *= sc;
        }
#pragma unroll
        for (int s = 0; s < 3; ++s) {
            h16x8 o;
#pragma unroll
            for (int j = 0; j < 8; ++j) o[j] = (h16)acc[s][j];
            *(h16x8*)(OUT[s] + (size_t)r * 512 + lane * 8) = o;
        }
        if (lane < 8) {
            const float bl = GL[(size_t)r * 16 + lane], al = GL[(size_t)r * 16 + 8 + lane];
            BETA[(size_t)r * 8 + lane] = sigmoid_f(bl);
            GDEC[(size_t)r * 8 + lane] = -expf(p.a_log[lane]) * softplus_f(al + p.dt_bias[lane]);
        }
    }
}

DI int seq_row(int dir, int pos) { return dir == 0 ? pos : (pos < CTXL ? (CTXL - 1 - pos) : (TPB + CTXL - 1 - pos)); }

DI void gdn_naive_block(const Params& p, float* lds, int blk) {
    const int tid = threadIdx.x, slot = tid >> 8, half = (tid >> 7) & 1, j = tid & 127;
    const int unit = blk * 2 + slot, b = unit >> 3, h = (unit >> 1) & 3, dir = unit & 1;
    const h16* QC = (const h16*)(p.ws + WS_QC); const h16* KC = (const h16*)(p.ws + WS_KC); const h16* VC = (const h16*)(p.ws + WS_VC);
    const float* BETA = (const float*)(p.ws + WS_BETA); const float* GDEC = (const float*)(p.ws + WS_GDEC);
    float* OG = p.out + (size_t)dir * NL * 512;
    float* kq = lds + slot * (8 * 2 * 128);
    float* xk = lds + 2 * (8 * 2 * 128) + slot * 256;
    float* xo = xk + 512;
    float S[64];
#pragma unroll
    for (int i = 0; i < 64; ++i) S[i] = 0.f;
    for (int pos0 = 0; pos0 < TPB; pos0 += 8) {
#pragma unroll
        for (int e = 0; e < 8; ++e) {
            const int idx = e * 256 + (tid & 255), tok = idx >> 8, which = (idx >> 7) & 1, d = idx & 127;
            const size_t r = (size_t)b * TPB + seq_row(dir, pos0 + tok);
            kq[idx] = (float)((which ? QC : KC)[r * 512 + h * 128 + d]);
        }
        __syncthreads();
        for (int tok = 0; tok < 8; ++tok) {
            const int t = seq_row(dir, pos0 + tok);
            const size_t r = (size_t)b * TPB + t;
            const float bt = BETA[r * 8 + dir * 4 + h], a = __expf(GDEC[r * 8 + dir * 4 + h]);
            const float v = (float)VC[r * 512 + h * 128 + j];
            const float* kk = kq + tok * 256 + half * 64; const float* qq = kk + 128;
            float ks = 0.f;
#pragma unroll
            for (int i = 0; i < 64; i += 4) { const f32x4 k4 = *(const f32x4*)(kk + i); ks += k4[0] * S[i] + k4[1] * S[i + 1] + k4[2] * S[i + 2] + k4[3] * S[i + 3]; }
            xk[half * 128 + j] = ks;
            __syncthreads();
            ks += xk[(1 - half) * 128 + j];
            const float cc = bt * (v - a * ks);
            float o = 0.f;
#pragma unroll
            for (int i = 0; i < 64; i += 4) {
                const f32x4 k4 = *(const f32x4*)(kk + i), q4 = *(const f32x4*)(qq + i);
                S[i] = a * S[i] + k4[0] * cc; S[i + 1] = a * S[i + 1] + k4[1] * cc; S[i + 2] = a * S[i + 2] + k4[2] * cc; S[i + 3] = a * S[i + 3] + k4[3] * cc;
                o += q4[0] * S[i] + q4[1] * S[i + 1] + q4[2] * S[i + 2] + q4[3] * S[i + 3];
            }
            xo[half * 128 + j] = o;
            __syncthreads();
            if (half == 0 && t >= CTXL) OG[((size_t)b * SEQ + (t - CTXL)) * 512 + h * 128 + j] = o + xo[128 + j];
        }
        __syncthreads();
    }
}

DI void s5_naive_wave(const Params& p, float* ubuf  , int u) {
    const int lane = threadIdx.x & 63, b = u >> 5, g = u & 31, pidx = lane;
    const h16* UG = (const h16*)(p.ws + WS_UG) + ((size_t)b * 32 + g) * TPB * 16;
    float* YS5 = (float*)(p.ws + WS_YS5); h16* G = (h16*)(p.ws + WS_G);
    for (int dir = 0; dir < 2; ++dir) {
        const int dg = dir * 32 + g;
        const double lre = p.lre[dg * 64 + pidx], lim = p.lim[dg * 64 + pidx], dt = (double)expf(p.logdt[dg]);
        double ang = lim * dt; ang -= 6.283185307179586477 * rint(ang * 0.15915494309189533577);
        float sn, cs; sincosf((float)ang, &sn, &cs);
        const double er = (double)expf((float)(lre * dt)), ar_d = er * (double)cs, ai_d = er * (double)sn;
        const double nr = ar_d - 1.0, ni = ai_d, den = lre * lre + lim * lim;
        const float cfr = (float)((nr * lre + ni * lim) / den), cfi = (float)((ni * lre - nr * lim) / den);
        const float ar = (float)ar_d, ai = (float)ai_d;
        float bbr[16], bbi[16], ccr[16], cci[16];
#pragma unroll
        for (int c = 0; c < 16; ++c) {
            const float br = p.bre[((size_t)dg * 64 + pidx) * 16 + c], bi = p.bim[((size_t)dg * 64 + pidx) * 16 + c];
            bbr[c] = cfr * br - cfi * bi; bbi[c] = cfr * bi + cfi * br;
            ccr[c] = p.cre[((size_t)dg * 16 + c) * 64 + pidx]; cci[c] = p.cim[((size_t)dg * 16 + c) * 64 + pidx];
        }
        float hr = 0.f, hi = 0.f;
        for (int pos0 = 0; pos0 < TPB; pos0 += 64) {
            {
                const int t = seq_row(dir, pos0 + lane);
                const h16x8 v0 = *(const h16x8*)(UG + (size_t)t * 16), v1 = *(const h16x8*)(UG + (size_t)t * 16 + 8);
#pragma unroll
                for (int c = 0; c < 8; ++c) { ubuf[lane * 16 + c] = (float)v0[c]; ubuf[lane * 16 + 8 + c] = (float)v1[c]; }
            }
            asm volatile("s_waitcnt lgkmcnt(0)" ::: "memory");
            for (int tk = 0; tk < 64; ++tk) {
                const int t = seq_row(dir, pos0 + tk);
                float uu[16];
#pragma unroll
                for (int c = 0; c < 16; c += 4) { const f32x4 q = *(const f32x4*)(ubuf + tk * 16 + c); uu[c] = q[0]; uu[c + 1] = q[1]; uu[c + 2] = q[2]; uu[c + 3] = q[3]; }
                float sr = 0.f, si = 0.f;
#pragma unroll
                for (int c = 0; c < 16; ++c) { sr += bbr[c] * uu[c]; si += bbi[c] * uu[c]; }
                const float nhr = ar * hr - ai * hi + sr, nhi = ar * hi + ai * hr + si;
                hr = nhr; hi = nhi;
                if (t >= CTXL) {
                    float v[16];
#pragma unroll
                    for (int c = 0; c < 16; ++c) v[c] = ccr[c] * hr - cci[c] * hi;
                    const bool b5 = (lane >> 5) & 1, b4 = (lane >> 4) & 1, b3 = (lane >> 3) & 1, b2 = (lane >> 2) & 1;
                    float w8[8], w4[4], w2[2], w1;
#pragma unroll
                    for (int i = 0; i < 8; ++i) { const float keep = b5 ? v[8 + i] : v[i], send = b5 ? v[i] : v[8 + i]; w8[i] = keep + __shfl_xor(send, 32); }
#pragma unroll
                    for (int i = 0; i < 4; ++i) { const float keep = b4 ? w8[4 + i] : w8[i], send = b4 ? w8[i] : w8[4 + i]; w4[i] = keep + __shfl_xor(send, 16); }
#pragma unroll
                    for (int i = 0; i < 2; ++i) { const float keep = b3 ? w4[2 + i] : w4[i], send = b3 ? w4[i] : w4[2 + i]; w2[i] = keep + __shfl_xor(send, 8); }
                    { const float keep = b2 ? w2[1] : w2[0], send = b2 ? w2[0] : w2[1]; w1 = keep + __shfl_xor(send, 4); }
                    w1 += __shfl_xor(w1, 2); w1 += __shfl_xor(w1, 1);
                    if ((lane & 3) == 0) {
                        const int c = lane >> 2;
                        const size_t o = ((size_t)b * SEQ + (t - CTXL)) * 512 + g * 16 + c;
                        if (dir == 0) YS5[o] = p.s5d[g * 16 + c] * ubuf[tk * 16 + c] + w1;
                        else G[o] = (h16)gelu_f(YS5[o] + w1);
                    }
                }
            }
            asm volatile("s_waitcnt lgkmcnt(0)" ::: "memory");
        }
    }
}

DI void phase_seq(const Params& p, float* lds) {
    if ((int)blockIdx.x < 64) { gdn_naive_block(p, lds, blockIdx.x); return; }
    const int wave = threadIdx.x >> 6;
    const int nw = ((int)gridDim.x - 64) * 8;
    for (int u = ((int)blockIdx.x - 64) * 8 + wave; u < 512; u += nw) s5_naive_wave(p, lds + wave * 1024, u);
}

DI void phase_mix(const Params& p, float* lds) {
    {
        ALoadF16 al{(const h16*)(p.ws + WS_G), 512};
        BLoadF32 bl{p.w_glu, 512};
        EpiGlu ep{(const h16*)(p.ws + WS_G), (const h16*)(p.ws + WS_ZS), p.b_glu, (h16*)(p.ws + WS_MIX)};
        gemm_naive(512, 512, NL / 128, 4, al, bl, ep, lds);
    }
    const int lane = threadIdx.x & 63, wave = threadIdx.x >> 6;
    const float* OGF = p.out; const float* OGR = p.out + (size_t)NL * 512;
    const h16* ZG = (const h16*)(p.ws + WS_ZG); h16* MIX = (h16*)(p.ws + WS_MIX);
    for (int r = blockIdx.x * 8 + wave; r < NL; r += gridDim.x * 8) {
        const int b = r / SEQ, tl = r % SEQ; const size_t rnt = (size_t)b * TPB + CTXL + tl;
        float o[8]; float ss = 0.f;
#pragma unroll
        for (int j = 0; j < 8; ++j) { o[j] = OGF[(size_t)r * 512 + lane * 8 + j] + OGR[(size_t)r * 512 + lane * 8 + j]; ss += o[j] * o[j]; }
        ss += __shfl_xor(ss, 1); ss += __shfl_xor(ss, 2); ss += __shfl_xor(ss, 4); ss += __shfl_xor(ss, 8);
        const float rs = rsqrtf(ss * (1.f / 128.f) + 1e-6f);
        const h16x8 z = *(const h16x8*)(ZG + rnt * 512 + lane * 8);
        h16x8 ov;
#pragma unroll
        for (int j = 0; j < 8; ++j) ov[j] = (h16)(o[j] * rs * p.norm_w[(lane * 8 + j) & 127] * silu_f((float)z[j]));
        *(h16x8*)(MIX + (size_t)r * 1024 + 512 + lane * 8) = ov;
    }
}

DI void phase_out(const Params& p, float* lds) {
    ALoadF16 al{(const h16*)(p.ws + WS_MIX), 1024};
    BLoadF32 bl{p.w_out, 1024};
    EpiF32Out ep{(float*)(p.ws + WS_Y), 1024};
    gemm_naive(1024, 1024, NL / 128, 8, al, bl, ep, lds);
}

DI void phase_ln(const Params& p) {
    const int lane = threadIdx.x & 63, wave = threadIdx.x >> 6;
    const float* ADA = (const float*)(p.ws + WS_ADA); const float* Y = (const float*)(p.ws + WS_Y);
    for (int r = blockIdx.x * 8 + wave; r < NL; r += gridDim.x * 8) {
        const int b = r / SEQ;
        f32x4 v[4]; float s = 0.f;
#pragma unroll
        for (int j = 0; j < 4; ++j) {
            const int k = j * 256 + lane * 4;
            const f32x4 xv = *(const f32x4*)(p.x + (size_t)r * DM + k), yv = *(const f32x4*)(Y + (size_t)r * DM + k), gt = *(const f32x4*)(ADA + b * 3072 + 2048 + k);
            v[j] = xv * DN_ALPHA + gt * yv;
            s += (v[j][0] + v[j][1]) + (v[j][2] + v[j][3]);
        }
#pragma unroll
        for (int o = 1; o < 64; o <<= 1) s += __shfl_xor(s, o);
        const float mean = s * (1.f / DM); float q = 0.f;
#pragma unroll
        for (int j = 0; j < 4; ++j) { v[j] = v[j] - mean; q += (v[j][0] * v[j][0] + v[j][1] * v[j][1]) + (v[j][2] * v[j][2] + v[j][3] * v[j][3]); }
#pragma unroll
        for (int o = 1; o < 64; o <<= 1) q += __shfl_xor(q, o);
        const float rstd = rsqrtf(q * (1.f / DM) + 1e-5f);
#pragma unroll
        for (int j = 0; j < 4; ++j) {
            const int k = j * 256 + lane * 4;
            const f32x4 gg = *(const f32x4*)(p.ln_g + k), bb = *(const f32x4*)(p.ln_b + k);
            *(f32x4*)(p.out + (size_t)r * DM + k) = v[j] * rstd * gg + bb;
        }
    }
}

constexpr int NPHASE = 7;
constexpr int LDS_BYTES = 147456;

template <bool COOP>
__global__ void __launch_bounds__(NTHR, 2) mega(Params p, int ph_lo, int ph_hi) {
    extern __shared__ __attribute__((aligned(16))) unsigned char smem[];
    float* lds = (float*)smem;
#ifndef ONLY_PHASE
#define ONLY_PHASE -1
#endif
#define PH_IN(k) (ph_lo <= (k) && (k) < ph_hi && (ONLY_PHASE < 0 || ONLY_PHASE == (k)))
#define PH_SYNC(k) do { if (COOP && PH_IN(k) && PH_IN((k) + 1)) cg::this_grid().sync(); } while (0)
    if (PH_IN(0)) phase_ada(p, lds);
    PH_SYNC(0);
    if (PH_IN(1)) phase_inproj(p, lds);
    PH_SYNC(1);
    if (PH_IN(2)) phase_gdn_prep(p);
    PH_SYNC(2);
    if (PH_IN(3)) phase_seq(p, lds);
    PH_SYNC(3);
    if (PH_IN(4)) phase_mix(p, lds);
    PH_SYNC(4);
    if (PH_IN(5)) phase_out(p, lds);
    PH_SYNC(5);
    if (PH_IN(6)) phase_ln(p);
}

extern "C" void kernel_launch(void* const* d_in, const int* in_sizes, int n_in, void* d_out, int out_size, void* d_ws, size_t ws_size,
                              hipStream_t stream) {
    static int grid = 0;
    if (grid == 0) {
        if (n_in != 24 || ws_size < WS_END) { fprintf(stderr, "kernel_launch: unexpected n_in %d / ws_size %zu\n", n_in, ws_size); grid = -1; return; }
        int dev = 0, cus = 0;
        hipGetDevice(&dev);
        hipDeviceGetAttribute(&cus, hipDeviceAttributeMultiprocessorCount, dev);
        hipFuncSetAttribute((const void*)mega<true>, hipFuncAttributeMaxDynamicSharedMemorySize, LDS_BYTES);
        hipFuncSetAttribute((const void*)mega<false>, hipFuncAttributeMaxDynamicSharedMemorySize, LDS_BYTES);
        int per_cu = 0;
        hipOccupancyMaxActiveBlocksPerMultiprocessor(&per_cu, (const void*)mega<true>, NTHR, LDS_BYTES);
        if (per_cu < 1) fprintf(stderr, "kernel_launch: occupancy query says %d blocks/CU\n", per_cu);
        (void)hipGetLastError();
        grid = cus > 0 ? cus : 256;
    }
    if (grid < 0) return;
    Params p{};
    const float** pp = (const float**)&p;
    for (int i = 0; i < 24; ++i) pp[i] = (const float*)d_in[i];
    p.out = (float*)d_out; p.ws = (unsigned char*)d_ws;
#if MK_ONE_LAUNCH
    int lo = 0, hi = NPHASE;
    void* args[] = {&p, &lo, &hi};
    hipError_t e = hipLaunchCooperativeKernel((const void*)mega<true>, dim3(grid), dim3(NTHR), args, LDS_BYTES, stream);
    if (e != hipSuccess) fprintf(stderr, "cooperative launch failed: %s (grid %d)\n", hipGetErrorString(e), grid);
#else
    for (int ph = 0; ph < NPHASE; ++ph) hipLaunchKernelGGL(mega<false>, dim3(grid), dim3(NTHR), LDS_BYTES, stream, p, ph, ph + 1);
#endif
}
```

```cpp
#include <hip/hip_runtime.h>
#include <hip/hip_cooperative_groups.h>
#include <cstdio>
#include <cstdint>
namespace cg = cooperative_groups;

#ifndef GDN_NAIVE
#define GDN_NAIVE 0
#endif
#ifndef MK_ONE_LAUNCH
#define MK_ONE_LAUNCH 1
#endif

typedef __bf16 h16;
typedef __bf16 h16x4 __attribute__((ext_vector_type(4)));
typedef __bf16 h16x8 __attribute__((ext_vector_type(8)));
typedef float f32x4 __attribute__((ext_vector_type(4)));
#define DI __device__ __forceinline__

constexpr int DM = 1024, NB = 16, SEQ = 2048, CTXL = 256, TPB = CTXL + SEQ  ;
constexpr int NT = NB * TPB  , NL = NB * SEQ  ;
constexpr int PIN = 3088;
constexpr int NTHR = 512;
constexpr float DN_ALPHA = 1.189207115002721f;

constexpr size_t MiB = 1u << 20;
constexpr size_t WS_CTL = 0, WS_ADA = 1 * MiB;
constexpr size_t WS_WINT = 2 * MiB  , WS_WOUTT = 10 * MiB  , WS_WGLUT = 12 * MiB  ;
constexpr size_t WS_HB = 252 * MiB  ;
constexpr int NIN_PAD = 3328;
constexpr size_t WS_TAB = 14 * MiB;
constexpr size_t WS_A16 = 26 * MiB;
constexpr size_t TAB_G_BYTES = 393216;
constexpr size_t WS_UG = 32 * MiB, WS_ZS = 68 * MiB, WS_QKV = 104 * MiB, WS_ZG = 212 * MiB, WS_GL = 248 * MiB;
constexpr size_t WS_QC = 252 * MiB  , WS_KT = 288 * MiB  , WS_VT = 324 * MiB, WS_BETA = 360 * MiB, WS_GDEC = 362 * MiB;
constexpr size_t WS_KC = 288 * MiB, WS_VC = 324 * MiB;
constexpr size_t WS_LOC = 364 * MiB;
constexpr size_t LOC_BYTES = 20480;
constexpr size_t WS_YS5 = 364 * MiB, WS_G = 456 * MiB, WS_MIX = 104 * MiB, WS_Y = 364 * MiB, WS_END = 512 * MiB;

struct Params {
    const float *x, *c, *ctx, *c_ctx, *w_ada, *b_ada, *w_in, *lre, *lim, *logdt, *bre, *bim, *cre, *cim, *s5d,
        *w_glu, *b_glu, *conv_w, *a_log, *dt_bias, *norm_w, *w_out, *ln_g, *ln_b;
    float* out;
    unsigned char* ws;
};

DI float silu_f(float v) { return v / (1.f + __expf(-v)); }
DI float sigmoid_f(float v) { return 1.f / (1.f + __expf(-v)); }
DI float gelu_f(float v) { return 0.5f * v * (1.f + erff(v * 0.70710678118654752f)); }
DI float softplus_f(float v) { return v > 20.f ? v : log1pf(expf(v)); }

DI void phase_ada(const Params& p, float* lds) {
    const int tid = threadIdx.x;
    if ((int)blockIdx.x >= 48) return;
    float* sc = lds;
    float* red = lds + 17 * 1024;
    float* ADA = (float*)(p.ws + WS_ADA);
    for (int i = tid; i < 17 * 1024; i += NTHR) {
        const int r = i >> 10, k = i & 1023;
        const float v = r < 16 ? p.c[r * 1024 + k] : p.c_ctx[k];
        sc[i] = silu_f(v);
    }
    __syncthreads();
    for (int unit = blockIdx.x; unit < 48; unit += gridDim.x) {
        const int ks = tid >> 6, col = tid & 63, n = unit * 64 + col;
#define ADA_ROWS(X) X(0) X(1) X(2) X(3) X(4) X(5) X(6) X(7) X(8) X(9) X(10) X(11) X(12) X(13) X(14) X(15) X(16)
#define ADA_DECL(r) float acc##r = 0.f;
#define ADA_FMA(r) acc##r += sc[(r) * 1024 + k] * w;
#define ADA_PUT(r) red[(ks * 17 + (r)) * 64 + col] = acc##r;
        ADA_ROWS(ADA_DECL)
        for (int k = ks * 128; k < ks * 128 + 128; ++k) {
            const float w = p.w_ada[(size_t)k * 3072 + n];
            ADA_ROWS(ADA_FMA)
        }
        ADA_ROWS(ADA_PUT)
#undef ADA_DECL
#undef ADA_FMA
#undef ADA_PUT
#undef ADA_ROWS
        __syncthreads();
        for (int i = tid; i < 17 * 64; i += NTHR) {
            const int r = i >> 6, cc = i & 63;
            float s = p.b_ada[unit * 64 + cc];
#pragma unroll
            for (int q = 0; q < 8; ++q) s += red[(q * 17 + r) * 64 + cc];
            ADA[r * 3072 + unit * 64 + cc] = s;
        }
        __syncthreads();
    }
}

template <class AL, class BL, class EP>
DI void gemm_naive(int N, int K, int ntm, int ntn, const AL& al, const BL& bl, const EP& ep, float* lds) {
    const int tid = threadIdx.x, ty = tid >> 5, tx = tid & 31;
    float* As = lds;
    float* Bs = lds + 16 * 132;
    for (int tile = blockIdx.x; tile < ntm * ntn; tile += gridDim.x) {
        const int tm = tile / ntn, tn = tile % ntn;
        f32x4 acc[8];
#pragma unroll
        for (int i = 0; i < 8; ++i) acc[i] = (f32x4){0.f, 0.f, 0.f, 0.f};
        const int arow = tm * 128 + (tid >> 2), akk = (tid & 3) * 4;
        const int bk = tid >> 5, bcol = tn * 128 + (tid & 31) * 4;
#pragma unroll 1
        for (int k0 = 0; k0 < K; k0 += 16) {
            const f32x4 a = al(arow, k0 + akk);
            f32x4 b = (f32x4){0.f, 0.f, 0.f, 0.f};
            if (bcol < N) b = bl(k0 + bk, bcol);
            __syncthreads();
#pragma unroll
            for (int j = 0; j < 4; ++j) As[(akk + j) * 132 + (tid >> 2)] = a[j];
            *(f32x4*)(Bs + bk * 128 + (tid & 31) * 4) = b;
            __syncthreads();
#pragma unroll
            for (int k = 0; k < 16; ++k) {
                const f32x4 a0 = *(const f32x4*)(As + k * 132 + ty * 8), a1 = *(const f32x4*)(As + k * 132 + ty * 8 + 4);
                const f32x4 bv = *(const f32x4*)(Bs + k * 128 + tx * 4);
                acc[0] += bv * a0[0]; acc[1] += bv * a0[1]; acc[2] += bv * a0[2]; acc[3] += bv * a0[3];
                acc[4] += bv * a1[0]; acc[5] += bv * a1[1]; acc[6] += bv * a1[2]; acc[7] += bv * a1[3];
            }
        }
        ep(tm * 128 + ty * 8, tn * 128 + tx * 4, acc);
    }
}

struct BLoadF32 {
    const float* w; int N;
    DI f32x4 operator()(int k, int col) const { return *(const f32x4*)(w + (size_t)k * N + col); }
};
struct ALoadF16 {
    const h16* a; int lda;
    DI f32x4 operator()(int row, int k) const {
        const h16x4 v = *(const h16x4*)(a + (size_t)row * lda + k);
        return (f32x4){(float)v[0], (float)v[1], (float)v[2], (float)v[3]};
    }
};
struct ALoadInproj {
    const float *x, *ctx, *ADA;
    DI f32x4 operator()(int row, int k) const {
        const int b = row / TPB, t = row % TPB;
        const float* src = t < CTXL ? ctx + ((size_t)b * CTXL + t) * DM : x + ((size_t)b * SEQ + (t - CTXL)) * DM;
        const int cr = t < CTXL ? 16 : b;
        const f32x4 v = *(const f32x4*)(src + k);
        const f32x4 sh = *(const f32x4*)(ADA + cr * 3072 + k), sc = *(const f32x4*)(ADA + cr * 3072 + 1024 + k);
        return v * (sc + 1.0f) + sh;
    }
};
DI h16x4 to_h4(const f32x4 a) { return (h16x4){(h16)a[0], (h16)a[1], (h16)a[2], (h16)a[3]}; }
struct EpiInproj {
    h16 *UG, *ZS, *QKV, *ZG; float* GL;
    DI void operator()(int r0, int c0, const f32x4 (&acc)[8]) const {
        if (c0 >= PIN) return;
#pragma unroll
        for (int i = 0; i < 8; ++i) {
            const int row = r0 + i, b = row / TPB, t = row % TPB;
            if (c0 < 512) *(h16x4*)(UG + (((size_t)b * 32 + (c0 >> 4)) * TPB + t) * 16 + (c0 & 15)) = to_h4(acc[i]);
            else if (c0 < 1024) *(h16x4*)(ZS + (size_t)row * 512 + (c0 - 512)) = to_h4(acc[i]);
            else if (c0 < 2560) *(h16x4*)(QKV + (size_t)row * 1536 + (c0 - 1024)) = to_h4(acc[i]);
            else if (c0 < 3072) *(h16x4*)(ZG + (size_t)row * 512 + (c0 - 2560)) = to_h4(acc[i]);
            else *(f32x4*)(GL + (size_t)row * 16 + (c0 - 3072)) = acc[i];
        }
    }
};
struct EpiGlu {
    const h16 *G, *ZS; const float* b_glu; h16* MIX;
    DI void operator()(int r0, int c0, const f32x4 (&acc)[8]) const {
#pragma unroll
        for (int i = 0; i < 8; ++i) {
            const int r = r0 + i, b = r / SEQ, tl = r % SEQ;
            const size_t rnt = (size_t)b * TPB + CTXL + tl;
            const h16x4 g = *(const h16x4*)(G + (size_t)r * 512 + c0), z = *(const h16x4*)(ZS + rnt * 512 + c0);
            f32x4 o;
#pragma unroll
            for (int j = 0; j < 4; ++j) o[j] = (float)g[j] * sigmoid_f(acc[i][j] + b_glu[c0 + j]) * silu_f((float)z[j]);
            *(h16x4*)(MIX + (size_t)r * 1024 + c0) = to_h4(o);
        }
    }
};
struct EpiF32Out {
    float* Y; int ldc;
    DI void operator()(int r0, int c0, const f32x4 (&acc)[8]) const {
#pragma unroll
        for (int i = 0; i < 8; ++i) *(f32x4*)(Y + (size_t)(r0 + i) * ldc + c0) = acc[i];
    }
};

DI void phase_inproj_naive(const Params& p, float* lds) {
    ALoadInproj al{p.x, p.ctx, (const float*)(p.ws + WS_ADA)};
    BLoadF32 bl{p.w_in, PIN};
    EpiInproj ep{(h16*)(p.ws + WS_UG), (h16*)(p.ws + WS_ZS), (h16*)(p.ws + WS_QKV), (h16*)(p.ws + WS_ZG), (float*)(p.ws + WS_GL)};
    gemm_naive(PIN, DM, NT / 128, (PIN + 127) / 128, al, bl, ep, lds);
}

namespace pg8 {
#define PG8_LAS __attribute__((address_space(3)))
typedef unsigned short bf16_t;
typedef short bf16x8 __attribute__((ext_vector_type(8)));
typedef float f32x4 __attribute__((ext_vector_type(4)));
typedef unsigned u32x4 __attribute__((ext_vector_type(4)));
constexpr int BM = 256, BK = 64, HALF = 128, HTB = HALF * BK * 2  , STAGE_BYTES = 8 * HTB, NXCD = 8, WGM = 8;

__host__ __device__ __forceinline__ int lds_byte(int r, int c) { const int st = (r >> 4) * 2 + (c >> 5), rr = r & 15, cc = c & 31, ob = rr * 64 + cc * 2; return st * 1024 + (ob ^ (((ob >> 9) & 1) << 5)); }
__host__ __device__ __forceinline__ void stage_rc(int b, int& R, int& C) { const int st = b / 1024, sb = b % 1024, swz = sb ^ (((sb >> 9) & 1) << 5); R = (st >> 1) * 16 + swz / 64; C = (st & 1) * 32 + (swz % 64) / 2; }
__host__ __device__ __forceinline__ int perm32(int rho) { const int n = rho >> 4, i = rho & 15; return 8 * (i >> 2) + 4 * n + (i & 3); }

struct Unit { int pm, pn; };
struct Gemm { const bf16_t* A; const bf16_t* Bt; int M, N, K; };

struct StaticOrder {
    int nM, nN, nwg, G, c;
    __host__ __device__ void init(int M, int N, int G_, int c_) { nM = M / BM; nN = N / BM; nwg = nM * nN; G = G_; c = c_; }
    __host__ __device__ bool next(int i, Unit& u) const {
        const long L = (long)i * G + c; if (L >= nwg) return false;
        int wgid = (int)L; { const int q = nwg / NXCD, r = nwg % NXCD, xcd = wgid % NXCD, off = wgid / NXCD; wgid = (xcd < r ? xcd * (q + 1) : r * (q + 1) + (xcd - r) * q) + off; }
        const int nig = WGM * nN, gid = wgid / nig, fm = gid * WGM, gsz = (nM - fm) < WGM ? (nM - fm) : WGM;
        u.pm = fm + ((wgid % nig) % gsz); u.pn = (wgid % nig) / gsz; return true;
    }
    __device__ __forceinline__ void a_ready(const Unit&) const {}
    __device__ __forceinline__ void done(const Unit&) const {}
};
__device__ __forceinline__ unsigned cvt_pk_bf16(float lo, float hi) { typedef __bf16 bf16v2_ __attribute__((ext_vector_type(2))); const bf16v2_ v = {(__bf16)lo, (__bf16)hi}; return __builtin_bit_cast(unsigned, v); }
typedef float f32x2 __attribute__((ext_vector_type(2)));
__device__ __forceinline__ f32x2 gelu_pk(f32x2 v) {
    const f32x2 av = __builtin_elementwise_abs(v), d = av * 0.2316418882f + 1.0f;
    f32x2 t; t.x = __builtin_amdgcn_rcpf(d.x); t.y = __builtin_amdgcn_rcpf(d.y);
    f32x2 q = t * 0.5307027145f + (-0.7265760135f); q = q * t + 0.7107068705f; q = q * t + (-0.142248368f); q = q * t + 0.127414796f; q = q * t;
    const f32x2 s = (v * v) * (-0.72134752044f);
    f32x2 e; e.x = __builtin_amdgcn_exp2f(s.x); e.y = __builtin_amdgcn_exp2f(s.y);
    const f32x2 m = v * (q * e), r = v - m;
    f32x2 o; o.x = v.x < 0.f ? m.x : r.x; o.y = v.y < 0.f ? m.y : r.y; return o;
}

struct EpiF32 {
    static constexpr bool PERM = false, AFTER_DRAIN = false;
    float* C; int ldc; const float* bias;
    __device__ __forceinline__ void operator()(const f32x4 (&acc)[2][2][4][2], const Unit& u, int wr, int wc, int fr, int fq) const {
        const int row0 = u.pm * BM + wr * 64 + fr, col0 = u.pn * BM + wc * 32 + 4 * fq;
        f32x4 bv[2][2];
#pragma unroll
        for (int bj = 0; bj < 2; ++bj)
#pragma unroll
            for (int n = 0; n < 2; ++n) bv[bj][n] = bias ? *(const f32x4*)(bias + col0 + bj * HALF + n * 16) : (f32x4){0.f, 0.f, 0.f, 0.f};
#pragma unroll
        for (int ai = 0; ai < 2; ++ai)
#pragma unroll
            for (int m = 0; m < 4; ++m) { float* rowp = C + (size_t)(row0 + ai * HALF + m * 16) * ldc + col0;
#pragma unroll
                for (int bj = 0; bj < 2; ++bj)
#pragma unroll
                    for (int n = 0; n < 2; ++n) *(f32x4*)(rowp + bj * HALF + n * 16) = acc[ai][bj][m][n] + bv[bj][n]; }
    }
};
template <class Epi, class Sched>
__device__ __forceinline__ void gemm_phase(PG8_LAS unsigned char* lds, const Gemm g, const Sched& S, const Epi& E) {
    const int tid = threadIdx.x, wid = __builtin_amdgcn_readfirstlane(tid >> 6), lane = tid & 63, wr = wid >> 2, wc = wid & 3, fr = lane & 15, fq = lane >> 4;
    const int K = g.K, nt = K / BK;
    unsigned voffA[2], voffB[2];
#pragma unroll
    for (int i = 0; i < 2; ++i) { int R, C; stage_rc(tid * 16 + i * 8192, R, C); const int Rb = Epi::PERM ? ((R & ~31) + perm32(R & 31)) : R;
        voffA[i] = (unsigned)(R * K + C) * 2u; voffB[i] = (unsigned)(Rb * K + C) * 2u; }
    const size_t kstep = (size_t)(BK * 2);
    const size_t hstep = (size_t)HALF * K * 2;
    const size_t tstep = 2 * hstep;
    const unsigned ldsw = (unsigned)wid * 1024u;
    const int aoff = lds_byte(wr * 64 + fr, fq * 8), boff = lds_byte(wc * 32 + fr, fq * 8);
#define PG8_SA(b, h) (((b) * 2 + (h)) * HTB)
#define PG8_SB(b, h) ((4 + (b) * 2 + (h)) * HTB)
#define PG8_STAGE(bufoff, gbase, voff) do { _Pragma("unroll") for (int _i = 0; _i < 2; ++_i) \
        __builtin_amdgcn_global_load_lds((const unsigned*)((const char*)(gbase) + (voff)[_i]), (PG8_LAS unsigned*)(lds + (bufoff) + ldsw + _i * 8192), 16, 0, 0); } while (0)
#define PG8_LDA(dst, b, h) do { _Pragma("unroll") for (int m = 0; m < 4; ++m) _Pragma("unroll") for (int k = 0; k < 2; ++k) dst[m][k] = *(const PG8_LAS bf16x8*)(lds + PG8_SA(b, h) + aoff + m * 2048 + k * 1024); } while (0)
#define PG8_LDB(dst, b, h) do { _Pragma("unroll") for (int n = 0; n < 2; ++n) _Pragma("unroll") for (int k = 0; k < 2; ++k) dst[n][k] = *(const PG8_LAS bf16x8*)(lds + PG8_SB(b, h) + boff + n * 2048 + k * 1024); } while (0)
#define PG8_MMA(ai, bj, At, Bt) do { __builtin_amdgcn_s_setprio(1); _Pragma("unroll") for (int m = 0; m < 4; ++m) _Pragma("unroll") for (int n = 0; n < 2; ++n) _Pragma("unroll") for (int k = 0; k < 2; ++k) \
        acc[ai][bj][m][n] = __builtin_amdgcn_mfma_f32_16x16x32_bf16(Bt[n][k], At[m][k], acc[ai][bj][m][n], 0, 0, 0); __builtin_amdgcn_s_setprio(0); } while (0)
#define PG8_WAIT_V(n) asm volatile("s_waitcnt vmcnt(" #n ")" ::: "memory")
#define PG8_WAIT_L(n) asm volatile("s_waitcnt lgkmcnt(" #n ")" ::: "memory")
#define PG8_BAR __builtin_amdgcn_s_barrier()
#define PG8_SCHED __builtin_amdgcn_sched_barrier(0)
    Unit cur, nxt; int ui = 0;
    if (!S.next(0, cur)) return;
    f32x4 acc[2][2][4][2];
#pragma unroll
    for (int a = 0; a < 2; ++a)
#pragma unroll
        for (int b = 0; b < 2; ++b)
#pragma unroll
            for (int m = 0; m < 4; ++m)
#pragma unroll
                for (int n = 0; n < 2; ++n) acc[a][b][m][n] = (f32x4){0.f, 0.f, 0.f, 0.f};
    bf16x8 At[4][2], B0[2][2], B1[2][2];
    const char* cA = (const char*)g.A + (size_t)cur.pm * tstep; const char* cB = (const char*)g.Bt + (size_t)cur.pn * tstep;
    S.a_ready(cur);
    PG8_STAGE(PG8_SB(0, 0), cB, voffB); PG8_STAGE(PG8_SA(0, 0), cA, voffA); PG8_STAGE(PG8_SB(0, 1), cB + hstep, voffB); PG8_STAGE(PG8_SA(0, 1), cA + hstep, voffA);
    if (wr == 1) PG8_BAR;
    PG8_WAIT_V(4); PG8_BAR;
    PG8_STAGE(PG8_SB(1, 0), cB + kstep, voffB); PG8_STAGE(PG8_SA(1, 0), cA + kstep, voffA); PG8_STAGE(PG8_SB(1, 1), cB + hstep + kstep, voffB);
    PG8_WAIT_V(6); PG8_BAR;
    for (;;) {
        const bool has_next = S.next(ui + 1, nxt);
        const char* nA = has_next ? (const char*)g.A + (size_t)nxt.pm * tstep : cA; const char* nB = has_next ? (const char*)g.Bt + (size_t)nxt.pn * tstep : cB;
        for (int t = 0; t < nt; t += 2) {
            const bool last = (t == nt - 2);
            const char* a1 = cA + (size_t)(t + 1) * kstep;
            const char* a2 = last ? nA : cA + (size_t)(t + 2) * kstep; const char* b2 = last ? nB : cB + (size_t)(t + 2) * kstep;
            const char* a3 = a2 + kstep; const char* b3 = b2 + kstep;
            if (last && has_next) S.a_ready(nxt);
            PG8_LDB(B0, 0, 0); PG8_SCHED; PG8_LDA(At, 0, 0); PG8_STAGE(PG8_SA(1, 1), a1 + hstep, voffA);
            PG8_WAIT_L(8); PG8_BAR; PG8_WAIT_L(0); PG8_MMA(0, 0, At, B0); PG8_BAR; PG8_SCHED;
            PG8_LDB(B1, 0, 1); PG8_STAGE(PG8_SB(0, 0), b2, voffB);
            PG8_BAR; PG8_WAIT_L(0); PG8_MMA(0, 1, At, B1); PG8_BAR;
            PG8_LDA(At, 0, 1); PG8_STAGE(PG8_SA(0, 0), a2, voffA);
            PG8_BAR; PG8_WAIT_L(0); PG8_MMA(1, 0, At, B0); PG8_BAR; PG8_SCHED;
            PG8_STAGE(PG8_SB(0, 1), b2 + hstep, voffB);
            PG8_WAIT_V(6); PG8_BAR; PG8_MMA(1, 1, At, B1); PG8_BAR;
            PG8_LDB(B0, 1, 0); PG8_SCHED; PG8_LDA(At, 1, 0); PG8_STAGE(PG8_SA(0, 1), a2 + hstep, voffA);
            PG8_WAIT_L(8); PG8_BAR; PG8_WAIT_L(0); PG8_MMA(0, 0, At, B0); PG8_BAR; PG8_SCHED;
            PG8_LDB(B1, 1, 1); PG8_STAGE(PG8_SB(1, 0), b3, voffB);
            PG8_BAR; PG8_WAIT_L(0); PG8_MMA(0, 1, At, B1); PG8_BAR;
            PG8_LDA(At, 1, 1); PG8_STAGE(PG8_SA(1, 0), a3, voffA);
            PG8_BAR; PG8_WAIT_L(0); PG8_MMA(1, 0, At, B0); PG8_BAR; PG8_SCHED;
            PG8_STAGE(PG8_SB(1, 1), b3 + hstep, voffB);
            PG8_WAIT_V(6); PG8_BAR; PG8_MMA(1, 1, At, B1); PG8_BAR;
        }
            if constexpr (!Epi::AFTER_DRAIN) { E(acc, cur, wr, wc, fr, fq); S.done(cur); }
            if (!has_next) break;
#pragma unroll
        for (int a = 0; a < 2; ++a)
#pragma unroll
            for (int b = 0; b < 2; ++b)
#pragma unroll
                for (int m = 0; m < 4; ++m)
#pragma unroll
                    for (int n = 0; n < 2; ++n) acc[a][b][m][n] = (f32x4){0.f, 0.f, 0.f, 0.f};
        cur = nxt; cA = nA; cB = nB; ++ui;
    }
    PG8_WAIT_V(0);
    if (wr == 0) PG8_BAR;
    PG8_BAR;
    if constexpr (Epi::AFTER_DRAIN) { E.fused(acc, cur, wr, wc, fr, fq, lds, wid, lane); S.done(cur); }
#undef PG8_SA
#undef PG8_SB
#undef PG8_STAGE
#undef PG8_LDA
#undef PG8_LDB
#undef PG8_MMA
#undef PG8_WAIT_V
#undef PG8_WAIT_L
#undef PG8_BAR
#undef PG8_SCHED
}
}

typedef pg8::bf16_t bf16_t;
typedef pg8::u32x4 u32x4;
DI float bf2f(unsigned short b) { return __uint_as_float(((unsigned)b) << 16); }
DI float bflo(unsigned w) { return __uint_as_float(w << 16); }
DI float bfhi(unsigned w) { return __uint_as_float(w & 0xffff0000u); }

DI void p0_transpose_item(const float* W, int ldw, int K, bf16_t* WT, float* scr, int kb, int nb, int nvalid, int lane) {
    const int k0 = 64 * kb, n0 = 32 * nb, cn = lane & 31;
#pragma unroll 8
    for (int i = 0; i < 32; ++i) { const int kk = 2 * i + (lane >> 5); scr[kk * 33 + cn] = cn < nvalid ? W[(size_t)(k0 + kk) * ldw + n0 + cn] : 0.f; }
    asm volatile("s_waitcnt lgkmcnt(0)" ::: "memory");
    const int c = lane & 7;
#pragma unroll
    for (int j = 0; j < 4; ++j) {
        const int n = (lane >> 3) + 8 * j; const float* sp = scr + (8 * c) * 33 + n;
        u32x4 o; o.x = pg8::cvt_pk_bf16(sp[0 * 33], sp[1 * 33]); o.y = pg8::cvt_pk_bf16(sp[2 * 33], sp[3 * 33]);
        o.z = pg8::cvt_pk_bf16(sp[4 * 33], sp[5 * 33]); o.w = pg8::cvt_pk_bf16(sp[6 * 33], sp[7 * 33]);
        *(u32x4*)(WT + (size_t)(n0 + n) * K + k0 + 8 * c) = o;
    }
    asm volatile("s_waitcnt lgkmcnt(0)" ::: "memory");
}
DI void phase_weights(const Params& p, float* lds) {
    const int lane = threadIdx.x & 63, wave = threadIdx.x >> 6;
    float* scr = lds + wave * (64 * 33);
    bf16_t* WinT = (bf16_t*)(p.ws + WS_WINT); bf16_t* WoutT = (bf16_t*)(p.ws + WS_WOUTT); bf16_t* WgluT = (bf16_t*)(p.ws + WS_WGLUT);
    constexpr int I_IN = 16 * 97, I_OUT = 16 * 32, I_GLU = 8 * 16;
    for (int it = blockIdx.x * 8 + wave; it < I_IN + I_OUT + I_GLU; it += gridDim.x * 8) {
        int r = it;
        if (r < I_IN) { const int kb = r / 97, nb = r % 97; p0_transpose_item(p.w_in, PIN, DM, WinT, scr, kb, nb, nb == 96 ? 16 : 32, lane); continue; }
        r -= I_IN;
        if (r < I_OUT) { p0_transpose_item(p.w_out, 1024, 1024, WoutT, scr, r / 32, r % 32, 32, lane); continue; }
        r -= I_OUT;
        p0_transpose_item(p.w_glu, 512, 512, WgluT, scr, r / 16, r % 16, 32, lane);
    }
    u32x4* z = (u32x4*)(WinT + (size_t)3104 * DM);
    for (int i = blockIdx.x * NTHR + threadIdx.x; i < 224 * DM / 8; i += gridDim.x * NTHR) z[i] = (u32x4){0u, 0u, 0u, 0u};
}
DI void phase_modulate(const Params& p) {
    const int lane = threadIdx.x & 63, wave = threadIdx.x >> 6;
    const float* ADA = (const float*)(p.ws + WS_ADA); bf16_t* HB = (bf16_t*)(p.ws + WS_HB);
    for (int r = blockIdx.x * 8 + wave; r < NT; r += gridDim.x * 8) {
        const int b = r / TPB, t = r % TPB;
        const float* src = t < CTXL ? p.ctx + ((size_t)b * CTXL + t) * DM : p.x + ((size_t)b * SEQ + (t - CTXL)) * DM;
        const float* ad = ADA + (t < CTXL ? 16 : b) * 3072;
#pragma unroll
        for (int j = 0; j < 2; ++j) {
            const int k = j * 512 + lane * 8;
            const f32x4 v0 = *(const f32x4*)(src + k), v1 = *(const f32x4*)(src + k + 4);
            const f32x4 s0 = *(const f32x4*)(ad + 1024 + k), s1 = *(const f32x4*)(ad + 1024 + k + 4), h0 = *(const f32x4*)(ad + k), h1 = *(const f32x4*)(ad + k + 4);
            const f32x4 a = v0 * (s0 + 1.0f) + h0, c = v1 * (s1 + 1.0f) + h1;
            u32x4 o; o.x = pg8::cvt_pk_bf16(a[0], a[1]); o.y = pg8::cvt_pk_bf16(a[2], a[3]); o.z = pg8::cvt_pk_bf16(c[0], c[1]); o.w = pg8::cvt_pk_bf16(c[2], c[3]);
            *(u32x4*)(HB + (size_t)r * DM + k) = o;
        }
    }
}
struct EpiInprojMK {
    static constexpr bool PERM = true, AFTER_DRAIN = false;
    bf16_t *UG, *ZS, *QKV, *ZG; float* GL;
    DI void operator()(const f32x4 (&acc)[2][2][4][2], const pg8::Unit& u, int wr, int wc, int fr, int fq) const {
        const int b = u.pm / 9, t0 = (u.pm % 9) * 256, pn = u.pn;
        const int cl0 = wc * 32 + 8 * fq;
        if (pn == 12) {
            if (cl0 < 16) {
#pragma unroll
                for (int ai = 0; ai < 2; ++ai)
#pragma unroll
                    for (int m = 0; m < 4; ++m) {
                        const size_t row = (size_t)u.pm * 256 + ai * 128 + wr * 64 + m * 16 + fr;
                        *(f32x4*)(GL + row * 16 + cl0) = acc[ai][0][m][0]; *(f32x4*)(GL + row * 16 + cl0 + 4) = acc[ai][0][m][1];
                    }
            }
            return;
        }
        bf16_t* base[2]; int rs, rowadd;
#pragma unroll
        for (int bj = 0; bj < 2; ++bj) {
            const int cl = cl0 + bj * 128;
            if (pn < 2) { const int col = pn * 256 + cl; base[bj] = UG + ((size_t)(b * 32 + (col >> 4)) * TPB) * 16 + (col & 15); }
            else if (pn < 4) base[bj] = ZS + (pn - 2) * 256 + cl;
            else if (pn < 10) base[bj] = QKV + (pn - 4) * 256 + cl;
            else base[bj] = ZG + (pn - 10) * 256 + cl;
        }
        if (pn < 2) { rs = 16; rowadd = t0; } else if (pn >= 4 && pn < 10) { rs = 1536; rowadd = u.pm * 256; } else { rs = 512; rowadd = u.pm * 256; }
#pragma unroll
        for (int ai = 0; ai < 2; ++ai)
#pragma unroll
            for (int m = 0; m < 4; ++m) {
                const size_t ro = (size_t)(rowadd + ai * 128 + wr * 64 + m * 16 + fr) * rs;
#pragma unroll
                for (int bj = 0; bj < 2; ++bj) {
                    const f32x4 v0 = acc[ai][bj][m][0], v1 = acc[ai][bj][m][1];
                    u32x4 w; w.x = pg8::cvt_pk_bf16(v0[0], v0[1]); w.y = pg8::cvt_pk_bf16(v0[2], v0[3]); w.z = pg8::cvt_pk_bf16(v1[0], v1[1]); w.w = pg8::cvt_pk_bf16(v1[2], v1[3]);
                    *(u32x4*)(base[bj] + ro) = w;
                }
            }
    }
};
struct EpiGluMK {
    static constexpr bool PERM = true, AFTER_DRAIN = false;
    const bf16_t *G, *ZS; const float* b_glu; bf16_t* MIX;
    DI void operator()(const f32x4 (&acc)[2][2][4][2], const pg8::Unit& u, int wr, int wc, int fr, int fq) const {
        const int b = u.pm / 8;
#pragma unroll
        for (int bj = 0; bj < 2; ++bj) {
            const int col = u.pn * 256 + bj * 128 + wc * 32 + 8 * fq;
            const f32x4 b0 = *(const f32x4*)(b_glu + col), b1 = *(const f32x4*)(b_glu + col + 4);
#pragma unroll
            for (int ai = 0; ai < 2; ++ai)
#pragma unroll
                for (int m = 0; m < 4; ++m) {
                    const int r = u.pm * 256 + ai * 128 + wr * 64 + m * 16 + fr;
                    const size_t rnt = (size_t)b * TPB + CTXL + (r - b * SEQ);
                    const u32x4 g = *(const u32x4*)(G + (size_t)r * 512 + col), z = *(const u32x4*)(ZS + rnt * 512 + col);
                    const f32x4 s0 = acc[ai][bj][m][0] + b0, s1 = acc[ai][bj][m][1] + b1;
                    float o[8];
                    o[0] = bflo(g.x) * sigmoid_f(s0[0]) * silu_f(bflo(z.x)); o[1] = bfhi(g.x) * sigmoid_f(s0[1]) * silu_f(bfhi(z.x));
                    o[2] = bflo(g.y) * sigmoid_f(s0[2]) * silu_f(bflo(z.y)); o[3] = bfhi(g.y) * sigmoid_f(s0[3]) * silu_f(bfhi(z.y));
                    o[4] = bflo(g.z) * sigmoid_f(s1[0]) * silu_f(bflo(z.z)); o[5] = bfhi(g.z) * sigmoid_f(s1[1]) * silu_f(bfhi(z.z));
                    o[6] = bflo(g.w) * sigmoid_f(s1[2]) * silu_f(bflo(z.w)); o[7] = bfhi(g.w) * sigmoid_f(s1[3]) * silu_f(bfhi(z.w));
                    u32x4 w; w.x = pg8::cvt_pk_bf16(o[0], o[1]); w.y = pg8::cvt_pk_bf16(o[2], o[3]); w.z = pg8::cvt_pk_bf16(o[4], o[5]); w.w = pg8::cvt_pk_bf16(o[6], o[7]);
                    *(u32x4*)(MIX + (size_t)r * 1024 + col) = w;
                }
        }
    }
};


typedef float f32x16 __attribute__((ext_vector_type(16)));
typedef unsigned u32x2 __attribute__((ext_vector_type(2)));
typedef pg8::bf16x8 bf16x8;
#define MFMA32(a, b, c) __builtin_amdgcn_mfma_f32_32x32x16_bf16((a), (b), (c), 0, 0, 0)

DI void s5_build_tables(const Params& p, float* lds, int g) {
    float* AP = lds;
    float* BB = lds + 4352;
    float* CC = lds + 8448;
    float* KK = lds + 12544;
    const int tid = threadIdx.x;
    if (tid < 128) {
        const int d = tid >> 6, pi = tid & 63, dg = d * 32 + g;
        const double lre = p.lre[dg * 64 + pi], lim = p.lim[dg * 64 + pi], dt = (double)expf(p.logdt[dg]);
        for (int tau = 0; tau <= 16; ++tau) {
            double ang = lim * dt * (double)tau; ang -= 6.283185307179586477 * rint(ang * 0.15915494309189533577);
            float sn, cs; sincosf((float)ang, &sn, &cs);
            const float mag = expf((float)(lre * dt * (double)tau));
            AP[((d * 64 + pi) * 17 + tau) * 2] = mag * cs; AP[((d * 64 + pi) * 17 + tau) * 2 + 1] = mag * sn;
        }
        const double ar_d = AP[((d * 64 + pi) * 17 + 1) * 2], ai_d = AP[((d * 64 + pi) * 17 + 1) * 2 + 1];
        const double nr = ar_d - 1.0, ni = ai_d, den = lre * lre + lim * lim;
        const float cfr = (float)((nr * lre + ni * lim) / den), cfi = (float)((ni * lre - nr * lim) / den);
        for (int c = 0; c < 16; ++c) {
            const float br = p.bre[((size_t)dg * 64 + pi) * 16 + c], bi = p.bim[((size_t)dg * 64 + pi) * 16 + c];
            BB[((d * 64 + pi) * 16 + c) * 2] = cfr * br - cfi * bi; BB[((d * 64 + pi) * 16 + c) * 2 + 1] = cfr * bi + cfi * br;
        }
        float* A16 = (float*)(p.ws + WS_A16) + ((g * 2 + d) * 64 + pi) * 2;
        A16[0] = AP[((d * 64 + pi) * 17 + 16) * 2]; A16[1] = AP[((d * 64 + pi) * 17 + 16) * 2 + 1];
    }
    for (int i = tid; i < 2 * 16 * 64; i += NTHR) {
        const int d = i >> 10, c = (i >> 6) & 15, pi = i & 63, dg = d * 32 + g;
        CC[i * 2] = p.cre[((size_t)dg * 16 + c) * 64 + pi]; CC[i * 2 + 1] = p.cim[((size_t)dg * 16 + c) * 64 + pi];
    }
    __syncthreads();
    for (int i = 0; i < 16; ++i) {
        const int idx = tid + NTHR * i, d = idx >> 12, tau = (idx >> 8) & 15, c = (idx >> 4) & 15, c2 = idx & 15;
        float sum = 0.f;
        for (int pi = 0; pi < 64; ++pi) {
            const float cr = CC[((d * 16 + c) * 64 + pi) * 2], ci = CC[((d * 16 + c) * 64 + pi) * 2 + 1];
            const float ar = AP[((d * 64 + pi) * 17 + tau) * 2], ai = AP[((d * 64 + pi) * 17 + tau) * 2 + 1];
            const float br = BB[((d * 64 + pi) * 16 + c2) * 2], bi = BB[((d * 64 + pi) * 16 + c2) * 2 + 1];
            const float xr = cr * ar - ci * ai, xi = cr * ai + ci * ar;
            sum += xr * br - xi * bi;
        }
        KK[idx] = sum;
    }
    __syncthreads();
    bf16_t* T1F = (bf16_t*)(p.ws + WS_TAB + (size_t)g * TAB_G_BYTES); bf16_t* T2F = T1F + 131072;
    for (int q = tid; q < 16384 + 8192; q += NTHR) {
        float v[8];
        if (q < 16384) {
            const int mt = q >> 10, ks = (q >> 6) & 15, ln = q & 63, row = mt * 32 + (ln & 31), hh = ln >> 5, sl = ks;
#pragma unroll
            for (int j = 0; j < 8; ++j) {
                const int c2 = 8 * hh + j;
                if (row < 256) {
                    const int tl = row >> 4, c = row & 15;
                    float val = 0.f;
                    if (sl <= tl) val += KK[((0 * 16 + (tl - sl)) * 16 + c) * 16 + c2];
                    if (sl >= tl) val += KK[((1 * 16 + (sl - tl)) * 16 + c) * 16 + c2];
                    if (sl == tl && c == c2) val += p.s5d[g * 16 + c];
                    v[j] = val;
                } else {
                    const int st = row - 256, d = st >> 7, ri = (st >> 6) & 1, pi = st & 63, tau = d ? sl : 15 - sl;
                    const float ar = AP[((d * 64 + pi) * 17 + tau) * 2], ai = AP[((d * 64 + pi) * 17 + tau) * 2 + 1];
                    const float br = BB[((d * 64 + pi) * 16 + c2) * 2], bi = BB[((d * 64 + pi) * 16 + c2) * 2 + 1];
                    v[j] = ri ? (ar * bi + ai * br) : (ar * br - ai * bi);
                }
            }
            u32x4 o; o.x = pg8::cvt_pk_bf16(v[0], v[1]); o.y = pg8::cvt_pk_bf16(v[2], v[3]); o.z = pg8::cvt_pk_bf16(v[4], v[5]); o.w = pg8::cvt_pk_bf16(v[6], v[7]);
            *(u32x4*)(T1F + (size_t)q * 8) = o;
        } else {
            const int q2 = q - 16384, mt = q2 >> 10, ks = (q2 >> 6) & 15, ln = q2 & 63, row = mt * 32 + (ln & 31), hh = ln >> 5, tl = row >> 4, c = row & 15;
#pragma unroll
            for (int j = 0; j < 8; ++j) {
                const int st = ks * 16 + 8 * hh + j, d = st >> 7, ri = (st >> 6) & 1, pi = st & 63, tau = d ? 16 - tl : tl + 1;
                const float cr = CC[((d * 16 + c) * 64 + pi) * 2], ci = CC[((d * 16 + c) * 64 + pi) * 2 + 1];
                const float ar = AP[((d * 64 + pi) * 17 + tau) * 2], ai = AP[((d * 64 + pi) * 17 + tau) * 2 + 1];
                v[j] = ri ? -(cr * ai + ci * ar) : (cr * ar - ci * ai);
            }
            u32x4 o; o.x = pg8::cvt_pk_bf16(v[0], v[1]); o.y = pg8::cvt_pk_bf16(v[2], v[3]); o.z = pg8::cvt_pk_bf16(v[4], v[5]); o.w = pg8::cvt_pk_bf16(v[6], v[7]);
            *(u32x4*)(T2F + (size_t)q2 * 8) = o;
        }
    }
}

DI void s5_unit(const Params& p, unsigned char* smem, int u) {
    const int tid = threadIdx.x, lane = tid & 63, wave = __builtin_amdgcn_readfirstlane(tid >> 6), b = u >> 5, g = u & 31;
    const int n31 = lane & 31, hh = lane >> 5;
    unsigned char* UT = smem;
    float* SH = (float*)smem;
    {
        const u32x4* src = (const u32x4*)((const bf16_t*)(p.ws + WS_UG) + (size_t)(b * 32 + g) * TPB * 16);
#pragma unroll
        for (int i = 0; i < 9; ++i) { const int q = tid + NTHR * i; *(u32x4*)(UT + (q >> 5) * 528 + (q & 31) * 16) = src[q]; }
    }
    __syncthreads();
    const u32x4* T1F = (const u32x4*)(p.ws + WS_TAB + (size_t)g * TAB_G_BYTES);
    const u32x4* T2F = T1F + 16384;
    f32x16 accY[4], accS[5];
#pragma unroll
    for (int j = 0; j < 4; ++j)
#pragma unroll
        for (int r = 0; r < 16; ++r) accY[j][r] = 0.f;
#pragma unroll
    for (int j = 0; j < 5; ++j)
#pragma unroll
        for (int r = 0; r < 16; ++r) accS[j][r] = 0.f;
    {
        const u32x4* aP = T1F + (size_t)(wave * 16) * 64 + lane;
#pragma unroll 4
        for (int ks = 0; ks < 16; ++ks) {
            const bf16x8 a = __builtin_bit_cast(bf16x8, aP[ks * 64]);
#pragma unroll
            for (int j = 0; j < 4; ++j) {
                const bf16x8 bv = *(const bf16x8*)(UT + (16 + 32 * j + n31) * 528 + ks * 32 + hh * 16);
                accY[j] = MFMA32(a, bv, accY[j]);
            }
        }
    }
    {
        const u32x4* aP = T1F + (size_t)((8 + wave) * 16) * 64 + lane;
#pragma unroll 4
        for (int ks = 0; ks < 16; ++ks) {
            const bf16x8 a = __builtin_bit_cast(bf16x8, aP[ks * 64]);
#pragma unroll
            for (int j = 0; j < 5; ++j) {
                const bf16x8 bv = *(const bf16x8*)(UT + (32 * j + n31) * 528 + ks * 32 + hh * 16);
                accS[j] = MFMA32(a, bv, accS[j]);
            }
        }
    }
    __syncthreads();
#pragma unroll
    for (int j = 0; j < 5; ++j) {
        const int n = 32 * j + n31;
        if (n < 144) {
#pragma unroll
            for (int q = 0; q < 4; ++q)
                *(f32x4*)(SH + n * 260 + wave * 32 + 8 * q + 4 * hh) = (f32x4){accS[j][4 * q], accS[j][4 * q + 1], accS[j][4 * q + 2], accS[j][4 * q + 3]};
        }
    }
    __syncthreads();
    if (tid < 128) {
        const int d = tid >> 6, pi = tid & 63;
        const float* A16 = (const float*)(p.ws + WS_A16) + ((g * 2 + d) * 64 + pi) * 2;
        const float ar = A16[0], ai = A16[1];
        float hr = 0.f, hi = 0.f;
        float* col = SH + d * 128 + pi;
        for (int s0 = 0; s0 < 144; s0 += 8) {
            float sr[8], si[8];
#pragma unroll
            for (int k = 0; k < 8; ++k) { const int st = s0 + k, n = d == 0 ? st : (st < 16 ? 15 - st : 159 - st); sr[k] = col[n * 260]; si[k] = col[n * 260 + 64]; }
#pragma unroll
            for (int k = 0; k < 8; ++k) {
                const int st = s0 + k, n = d == 0 ? st : (st < 16 ? 15 - st : 159 - st);
                col[n * 260] = hr; col[n * 260 + 64] = hi;
                const float nr = ar * hr - ai * hi + sr[k], ni = ar * hi + ai * hr + si[k];
                hr = nr; hi = ni;
            }
        }
    }
    __syncthreads();
    {
        const u32x4* aP = T2F + (size_t)(wave * 16) * 64 + lane;
#pragma unroll 4
        for (int ks = 0; ks < 16; ++ks) {
            const bf16x8 a = __builtin_bit_cast(bf16x8, aP[ks * 64]);
#pragma unroll
            for (int j = 0; j < 4; ++j) {
                const float* hp = SH + (16 + 32 * j + n31) * 260 + ks * 16 + 8 * hh;
                const f32x4 x0 = *(const f32x4*)hp, x1 = *(const f32x4*)(hp + 4);
                u32x4 w; w.x = pg8::cvt_pk_bf16(x0[0], x0[1]); w.y = pg8::cvt_pk_bf16(x0[2], x0[3]); w.z = pg8::cvt_pk_bf16(x1[0], x1[1]); w.w = pg8::cvt_pk_bf16(x1[2], x1[3]);
                accY[j] = MFMA32(a, __builtin_bit_cast(bf16x8, w), accY[j]);
            }
        }
    }
    {
        bf16_t* G = (bf16_t*)(p.ws + WS_G);
#pragma unroll
        for (int j = 0; j < 4; ++j) {
            const int tokbase = 16 * (32 * j + n31);
#pragma unroll
            for (int q = 0; q < 4; ++q) {
                const int cr0 = 8 * q + 4 * hh, tl = 2 * wave + (cr0 >> 4), c0 = cr0 & 15;
                u32x2 w; w.x = pg8::cvt_pk_bf16(gelu_f(accY[j][4 * q]), gelu_f(accY[j][4 * q + 1])); w.y = pg8::cvt_pk_bf16(gelu_f(accY[j][4 * q + 2]), gelu_f(accY[j][4 * q + 3]));
                *(u32x2*)(G + ((size_t)b * SEQ + tokbase + tl) * 512 + g * 16 + c0) = w;
            }
        }
    }
    __syncthreads();
}


#define MFMA16(a, b, c) __builtin_amdgcn_mfma_f32_16x16x32_bf16((a), (b), (c), 0, 0, 0)
DI bf16x8 mk8(unsigned a, unsigned b, unsigned c, unsigned d) { u32x4 w; w.x = a; w.y = b; w.z = c; w.w = d; return __builtin_bit_cast(bf16x8, w); }
DI bf16x8 packlo(const f32x4 a) { return mk8(pg8::cvt_pk_bf16(a[0], a[1]), pg8::cvt_pk_bf16(a[2], a[3]), 0u, 0u); }
DI bf16x8 pack2(const f32x4 a, const f32x4 b) { return mk8(pg8::cvt_pk_bf16(a[0], a[1]), pg8::cvt_pk_bf16(a[2], a[3]), pg8::cvt_pk_bf16(b[0], b[1]), pg8::cvt_pk_bf16(b[2], b[3])); }
DI bf16x8 ld_pair(const unsigned char* rowp, int off_lo, int off_hi) { const u32x2 lo = *(const u32x2*)(rowp + off_lo), hi = *(const u32x2*)(rowp + off_hi); return mk8(lo.x, lo.y, hi.x, hi.y); }
DI bf16x8 ld_single(const unsigned char* rowp, int off) { const u32x2 lo = *(const u32x2*)(rowp + off); return mk8(lo.x, lo.y, 0u, 0u); }
DI void st_bf16(unsigned char* p, float v) { *(unsigned short*)p = (unsigned short)(pg8::cvt_pk_bf16(v, 0.f) & 0xffffu); }

constexpr int LQ_OFF = 0, LK_OFF = 17408, LV_OFF = 34816;
constexpr int LGT_OFF = 52224;
constexpr int LAF_OFF = 55808;
constexpr int LNA_OFF = 64000, LPP_OFF = 80384, LXI_OFF = 96768;
constexpr int GQ_OFF = 0, GKT_OFF = 17408, GVT_OFF = 35840, GW_OFF = 54272, GP_OFF = 71680, GNA_OFF = 80896, GXI_OFF = 90112, GGT_OFF = 93184;

DI void phase_gdn_local(const Params& p, unsigned char* smem) {
    const int tid = threadIdx.x, lane = tid & 63, wave = __builtin_amdgcn_readfirstlane(tid >> 6);
    const int r16 = lane & 15, kq = lane >> 4;
    const bf16_t* QKV = (const bf16_t*)(p.ws + WS_QKV);
    const float* GL = (const float*)(p.ws + WS_GL);
    bf16_t* QC = (bf16_t*)(p.ws + WS_QC); bf16_t* KTg = (bf16_t*)(p.ws + WS_KT); bf16_t* VTg = (bf16_t*)(p.ws + WS_VT);
    float* GT = (float*)(smem + LGT_OFF); float* AF = (float*)(smem + LAF_OFF);
    for (int unit = blockIdx.x; unit < NB * 36; unit += gridDim.x) {
        const int b = unit / 36, c = unit % 36;
        const size_t rowbase = (size_t)b * TPB + 64 * c;
        for (int h = 0; h < 4; ++h) {
            for (int it = 0; it < 8; ++it) {
                const int tk = wave * 8 + it, t = 64 * c + tk;
                float acc[3][2] = {{0.f, 0.f}, {0.f, 0.f}, {0.f, 0.f}};
                if (t < CTXL) {
                    for (int kx = 0; kx < 3; ++kx) {
                        const int tt = t + kx - 1;
                        if (tt < 0 || tt >= CTXL) continue;
                        const size_t rr = (size_t)b * TPB + tt;
#pragma unroll
                        for (int sct = 0; sct < 3; ++sct) {
                            const unsigned v = *(const unsigned*)(QKV + rr * 1536 + sct * 512 + h * 128 + 2 * lane);
                            const float* w = p.conv_w + (3 + kx) * 1536 + sct * 512 + h * 128 + 2 * lane;
                            acc[sct][0] += bflo(v) * w[0]; acc[sct][1] += bfhi(v) * w[1];
                        }
                    }
                } else {
                    const int tl = t - CTXL, gy = tl >> 6, gx = tl & 63;
                    for (int ky = 0; ky < 3; ++ky) {
                        const int yy = gy + ky - 1;
                        if (yy < 0 || yy >= 32) continue;
                        for (int kx = 0; kx < 3; ++kx) {
                            const int xx = gx + kx - 1;
                            if (xx < 0 || xx >= 64) continue;
                            const size_t rr = (size_t)b * TPB + CTXL + yy * 64 + xx;
#pragma unroll
                            for (int sct = 0; sct < 3; ++sct) {
                                const unsigned v = *(const unsigned*)(QKV + rr * 1536 + sct * 512 + h * 128 + 2 * lane);
                                const float* w = p.conv_w + (ky * 3 + kx) * 1536 + sct * 512 + h * 128 + 2 * lane;
                                acc[sct][0] += bflo(v) * w[0]; acc[sct][1] += bfhi(v) * w[1];
                            }
                        }
                    }
                }
#pragma unroll
                for (int sct = 0; sct < 3; ++sct) { acc[sct][0] = silu_f(acc[sct][0]); acc[sct][1] = silu_f(acc[sct][1]); }
#pragma unroll
                for (int sct = 0; sct < 2; ++sct) {
                    float ss = acc[sct][0] * acc[sct][0] + acc[sct][1] * acc[sct][1];
#pragma unroll
                    for (int o = 1; o < 64; o <<= 1) ss += __shfl_xor(ss, o);
                    const float sc = rsqrtf(ss + 1e-6f) * (sct == 0 ? 0.08838834764831845f : 1.0f);
                    acc[sct][0] *= sc; acc[sct][1] *= sc;
                }
                const unsigned qw = pg8::cvt_pk_bf16(acc[0][0], acc[0][1]), kw = pg8::cvt_pk_bf16(acc[1][0], acc[1][1]), vw = pg8::cvt_pk_bf16(acc[2][0], acc[2][1]);
                *(unsigned*)(smem + LQ_OFF + tk * 272 + lane * 4) = qw;
                *(unsigned*)(smem + LK_OFF + tk * 272 + lane * 4) = kw;
                *(unsigned*)(smem + LV_OFF + tk * 272 + lane * 4) = vw;
                *(unsigned*)(QC + (rowbase + tk) * 512 + h * 128 + 2 * lane) = qw;
#if GDN_NAIVE
                *(unsigned*)((bf16_t*)(p.ws + WS_KC) + (rowbase + tk) * 512 + h * 128 + 2 * lane) = kw;
                *(unsigned*)((bf16_t*)(p.ws + WS_VC) + (rowbase + tk) * 512 + h * 128 + 2 * lane) = vw;
#endif
            }
            if (tid < 128) {
                const int d = tid >> 6, tok = tid & 63, j = d * 4 + h;
                const size_t r = rowbase + tok;
                const float be = sigmoid_f(GL[r * 16 + j]);
                const float g = -expf(p.a_log[j]) * softplus_f(GL[r * 16 + 8 + j] + p.dt_bias[j]);
                GT[(d * 6 + 0) * 64 + tok] = g; GT[(d * 6 + 4) * 64 + tok] = be;
#if GDN_NAIVE
                ((float*)(p.ws + WS_BETA))[r * 8 + j] = be; ((float*)(p.ws + WS_GDEC))[r * 8 + j] = g;
#endif
            }
            __syncthreads();
            if (wave < 2) {
                const int d = wave;
                float x = GT[(d * 6 + 0) * 64 + lane];
#pragma unroll
                for (int o = 1; o < 64; o <<= 1) {
                    const float y = d == 0 ? __shfl_up(x, o) : __shfl_down(x, o);
                    const bool ok = d == 0 ? (lane >= o) : (lane + o < 64);
                    if (ok) x += y;
                }
                const float tot = __shfl(x, d == 0 ? 63 : 0);
                const float gam = __expf(x), be = GT[(d * 6 + 4) * 64 + lane];
                GT[(d * 6 + 1) * 64 + lane] = x; GT[(d * 6 + 2) * 64 + lane] = gam; GT[(d * 6 + 3) * 64 + lane] = __expf(tot - x);
                GT[(d * 6 + 5) * 64 + lane] = be * gam;
                if (lane == 0) GT[12 * 64 + d] = __expf(tot);
            }
            __syncthreads();
            {
                const int mi = wave >> 1;
                f32x4 aK[2] = {{0.f, 0.f, 0.f, 0.f}, {0.f, 0.f, 0.f, 0.f}}, aQ[2] = {{0.f, 0.f, 0.f, 0.f}, {0.f, 0.f, 0.f, 0.f}};
#pragma unroll
                for (int ks = 0; ks < 4; ++ks) {
                    const bf16x8 fk = *(const bf16x8*)(smem + LK_OFF + (16 * mi + r16) * 272 + (32 * ks + 8 * kq) * 2);
                    const bf16x8 fq = *(const bf16x8*)(smem + LQ_OFF + (16 * mi + r16) * 272 + (32 * ks + 8 * kq) * 2);
#pragma unroll
                    for (int tt = 0; tt < 2; ++tt) {
                        const int nj = 2 * (wave & 1) + tt;
                        const bf16x8 fb = *(const bf16x8*)(smem + LK_OFF + (16 * nj + r16) * 272 + (32 * ks + 8 * kq) * 2);
                        aK[tt] = MFMA16(fk, fb, aK[tt]); aQ[tt] = MFMA16(fq, fb, aQ[tt]);
                    }
                }
#pragma unroll
                for (int tt = 0; tt < 2; ++tt) {
                    const int nj = 2 * (wave & 1) + tt, j = 16 * nj + r16;
#pragma unroll
                    for (int d = 0; d < 2; ++d) {
                        const float gcj = GT[(d * 6 + 1) * 64 + j];
#pragma unroll
                        for (int r = 0; r < 4; ++r) {
                            const int i = 16 * mi + 4 * kq + r;
                            const bool strict = d ? (j > i) : (j < i), incl = strict || (i == j);
                            const float e = incl ? __expf(GT[(d * 6 + 1) * 64 + i] - gcj) : 0.f;
                            const float a = strict ? GT[(d * 6 + 4) * 64 + i] * aK[tt][r] * e : 0.f;
                            st_bf16(smem + LNA_OFF + ((d * 64 + i) * 64 + j) * 2, -a);
                            st_bf16(smem + LPP_OFF + ((d * 64 + i) * 64 + j) * 2, aQ[tt][r] * e);
                            if (mi == nj) AF[((d * 4 + mi) * 16 + 4 * kq + r) * 16 + r16] = a;
                        }
                    }
                }
            }
            __syncthreads();
            if (lane < 16) {
                const int d = wave >> 2, I = wave & 3, cc = lane;
                const float* ab = AF + (d * 4 + I) * 256;
                float x[16];
                if (d == 0) {
#pragma unroll
                    for (int i = 0; i < 16; ++i) { float sacc = (i == cc) ? 1.f : 0.f;
#pragma unroll
                        for (int j = 0; j < 16; ++j) if (j < i) sacc -= ab[i * 16 + j] * x[j];
                        x[i] = sacc; }
                } else {
#pragma unroll
                    for (int ii = 0; ii < 16; ++ii) { const int i = 15 - ii; float sacc = (i == cc) ? 1.f : 0.f;
#pragma unroll
                        for (int j = 0; j < 16; ++j) if (j > i) sacc -= ab[i * 16 + j] * x[j];
                        x[i] = sacc; }
                }
#pragma unroll
                for (int i = 0; i < 16; ++i) st_bf16(smem + LXI_OFF + ((d * 64 + 16 * I + i) * 16 + cc) * 2, x[i]);
            }
            __syncthreads();
#if !GDN_NAIVE
            {
                const size_t tile = ((size_t)(b * 4 + h) * 36 + c) * 8192;
                for (int q = tid; q < 2048; q += NTHR) {
                    const int mat = q >> 10, qq = q & 1023, dd = qq >> 3, t8 = qq & 7;
                    const unsigned char* src = smem + (mat ? LV_OFF : LK_OFF) + dd * 2;
                    unsigned short e[8];
#pragma unroll
                    for (int jj = 0; jj < 8; ++jj) e[jj] = *(const unsigned short*)(src + (8 * t8 + jj) * 272);
                    u32x4 o; o.x = e[0] | ((unsigned)e[1] << 16); o.y = e[2] | ((unsigned)e[3] << 16); o.z = e[4] | ((unsigned)e[5] << 16); o.w = e[6] | ((unsigned)e[7] << 16);
                    *(u32x4*)((mat ? VTg : KTg) + tile + (size_t)qq * 8) = o;
                }
                for (int q = tid; q < 2 * 1232; q += NTHR) {
                    const int d = q / 1232, qq = q % 1232;
                    unsigned char* dst = p.ws + WS_LOC + ((size_t)((b * 4 + h) * 2 + d) * 36 + c) * LOC_BYTES;
                    u32x4 v;
                    if (qq < 512) v = *(const u32x4*)(smem + LNA_OFF + d * 8192 + qq * 16);
                    else if (qq < 1024) v = *(const u32x4*)(smem + LPP_OFF + d * 8192 + (qq - 512) * 16);
                    else if (qq < 1152) v = *(const u32x4*)(smem + LXI_OFF + d * 2048 + (qq - 1024) * 16);
                    else { const int gq = qq - 1152; v = *(const u32x4*)(smem + LGT_OFF + ((d * 6 + 2) * 64) * 4 + gq * 16); if (gq >= 64) v = (u32x4){__float_as_uint(GT[12 * 64 + d]), 0u, 0u, 0u}; }
                    *(u32x4*)(dst + qq * 16) = v;
                }
            }
#endif
            __syncthreads();
        }
    }
}

DI void gdn_tri_solve(f32x4 (&R)[4], const unsigned char* NA, const unsigned char* XI, int dir, int r16, int kq) {
    const f32x4 z4 = (f32x4){0.f, 0.f, 0.f, 0.f};
#define NA_ROW(I) (NA + (16 * (I) + r16) * 144)
#define XI_F(I) ld_single(XI + (16 * (I) + r16) * 48, kq * 8)
    if (dir == 0) {
        R[0] = MFMA16(XI_F(0), packlo(R[0]), z4);
        R[1] = MFMA16(ld_single(NA_ROW(1), (0 + 4 * kq) * 2), packlo(R[0]), R[1]);
        R[1] = MFMA16(XI_F(1), packlo(R[1]), z4);
        R[2] = MFMA16(ld_pair(NA_ROW(2), (0 + 4 * kq) * 2, (16 + 4 * kq) * 2), pack2(R[0], R[1]), R[2]);
        R[2] = MFMA16(XI_F(2), packlo(R[2]), z4);
        R[3] = MFMA16(ld_pair(NA_ROW(3), (0 + 4 * kq) * 2, (16 + 4 * kq) * 2), pack2(R[0], R[1]), R[3]);
        R[3] = MFMA16(ld_single(NA_ROW(3), (32 + 4 * kq) * 2), packlo(R[2]), R[3]);
        R[3] = MFMA16(XI_F(3), packlo(R[3]), z4);
    } else {
        R[3] = MFMA16(XI_F(3), packlo(R[3]), z4);
        R[2] = MFMA16(ld_single(NA_ROW(2), (48 + 4 * kq) * 2), packlo(R[3]), R[2]);
        R[2] = MFMA16(XI_F(2), packlo(R[2]), z4);
        R[1] = MFMA16(ld_pair(NA_ROW(1), (32 + 4 * kq) * 2, (48 + 4 * kq) * 2), pack2(R[2], R[3]), R[1]);
        R[1] = MFMA16(XI_F(1), packlo(R[1]), z4);
        R[0] = MFMA16(ld_pair(NA_ROW(0), (32 + 4 * kq) * 2, (48 + 4 * kq) * 2), pack2(R[2], R[3]), R[0]);
        R[0] = MFMA16(ld_single(NA_ROW(0), (16 + 4 * kq) * 2), packlo(R[1]), R[0]);
        R[0] = MFMA16(XI_F(0), packlo(R[0]), z4);
    }
#undef NA_ROW
#undef XI_F
}

DI void gdn_unit(const Params& p, unsigned char* smem, int u) {
    const int tid = threadIdx.x, lane = tid & 63, wave = __builtin_amdgcn_readfirstlane(tid >> 6);
    const int b = u >> 3, h = (u >> 1) & 3, dir = u & 1;
    const int r16 = lane & 15, kq = lane >> 4;
    const unsigned char* QCb = (const unsigned char*)(p.ws + WS_QC) + ((size_t)b * TPB * 512 + h * 128) * 2;
    const unsigned char* KTb = (const unsigned char*)(p.ws + WS_KT) + (size_t)(b * 4 + h) * 36 * 16384;
    const unsigned char* VTb = (const unsigned char*)(p.ws + WS_VT) + (size_t)(b * 4 + h) * 36 * 16384;
    const unsigned char* LOCb = (const unsigned char*)(p.ws + WS_LOC) + (size_t)((b * 4 + h) * 2 + dir) * 36 * LOC_BYTES;
    float* OG = p.out + (size_t)dir * NL * 512;
    const float* GGT = (const float*)(smem + GGT_OFF);
    f32x4 Sacc[8]; bf16x8 Sb[4];
#pragma unroll
    for (int m = 0; m < 8; ++m) Sacc[m] = (f32x4){0.f, 0.f, 0.f, 0.f};
#pragma unroll
    for (int ks = 0; ks < 4; ++ks) Sb[ks] = mk8(0u, 0u, 0u, 0u);
    u32x4 pf[9];
#define GDN_CHUNK(st) (dir == 0 ? (st) : ((st) < 4 ? 3 - (st) : 39 - (st)))
#define GDN_PREFETCH(cc) do { _Pragma("unroll") for (int i_ = 0; i_ < 9; ++i_) { const int q_ = tid + NTHR * i_; \
        const unsigned char* s_; \
        if (i_ < 2) s_ = QCb + (size_t)(64 * (cc) + (q_ >> 4)) * 1024 + (q_ & 15) * 16; \
        else if (i_ < 4) s_ = KTb + (size_t)(cc) * 16384 + (q_ - 1024) * 16; \
        else if (i_ < 6) s_ = VTb + (size_t)(cc) * 16384 + (q_ - 2048) * 16; \
        else s_ = LOCb + (size_t)(cc) * LOC_BYTES + (q_ - 3072) * 16; \
        if (q_ < 4304) pf[i_] = *(const u32x4*)s_; } } while (0)
    GDN_PREFETCH(GDN_CHUNK(0));
    for (int st = 0; st < 36; ++st) {
        const int c = GDN_CHUNK(st);
        __syncthreads();
#pragma unroll
        for (int i = 0; i < 9; ++i) {
            const int q = tid + NTHR * i; unsigned char* dptr;
            if (i < 2) dptr = smem + GQ_OFF + (q >> 4) * 272 + (q & 15) * 16;
            else if (i < 4) dptr = smem + GKT_OFF + ((q - 1024) >> 3) * 144 + ((q - 1024) & 7) * 16;
            else if (i < 6) dptr = smem + GVT_OFF + ((q - 2048) >> 3) * 144 + ((q - 2048) & 7) * 16;
            else if (i < 7) dptr = smem + GNA_OFF + ((q - 3072) >> 3) * 144 + ((q - 3072) & 7) * 16;
            else if (i < 8) dptr = smem + GP_OFF + ((q - 3584) >> 3) * 144 + ((q - 3584) & 7) * 16;
            else if (q < 4224) dptr = smem + GXI_OFF + ((q - 4096) >> 1) * 48 + ((q - 4096) & 1) * 16;
            else dptr = smem + GGT_OFF + (q - 4224) * 16;
            if (q < 4304) *(u32x4*)dptr = pf[i];
        }
        if (st + 1 < 36) { const int cn = GDN_CHUNK(st + 1); GDN_PREFETCH(cn); }
        __syncthreads();
        {
            f32x4 R[4];
#pragma unroll
            for (int mi = 0; mi < 4; ++mi) {
                const u32x2 kv = *(const u32x2*)(smem + GKT_OFF + (16 * wave + r16) * 144 + (16 * mi + 4 * kq) * 2);
                const f32x4 bg = *(const f32x4*)(GGT + 192 + 16 * mi + 4 * kq);
                R[mi] = (f32x4){bflo(kv.x) * bg[0], bfhi(kv.x) * bg[1], bflo(kv.y) * bg[2], bfhi(kv.y) * bg[3]};
            }
            gdn_tri_solve(R, smem + GNA_OFF, smem + GXI_OFF, dir, r16, kq);
#pragma unroll
            for (int mi = 0; mi < 4; ++mi)
#pragma unroll
                for (int r = 0; r < 4; ++r) st_bf16(smem + GW_OFF + (16 * mi + 4 * kq + r) * 272 + (16 * wave + r16) * 2, R[mi][r]);
        }
        __syncthreads();
        f32x4 U[4], WS[4], QS[4];
#pragma unroll
        for (int mi = 0; mi < 4; ++mi) {
            const u32x2 vv = *(const u32x2*)(smem + GVT_OFF + (16 * wave + r16) * 144 + (16 * mi + 4 * kq) * 2);
            const f32x4 be = *(const f32x4*)(GGT + 128 + 16 * mi + 4 * kq);
            U[mi] = (f32x4){bflo(vv.x) * be[0], bfhi(vv.x) * be[1], bflo(vv.y) * be[2], bfhi(vv.y) * be[3]};
            WS[mi] = (f32x4){0.f, 0.f, 0.f, 0.f}; QS[mi] = (f32x4){0.f, 0.f, 0.f, 0.f};
        }
        gdn_tri_solve(U, smem + GNA_OFF, smem + GXI_OFF, dir, r16, kq);
#pragma unroll
        for (int ks = 0; ks < 4; ++ks)
#pragma unroll
            for (int mi = 0; mi < 4; ++mi) {
                const bf16x8 fw = ld_pair(smem + GW_OFF + (16 * mi + r16) * 272, (32 * ks + 4 * kq) * 2, (32 * ks + 16 + 4 * kq) * 2);
                const bf16x8 fq = ld_pair(smem + GQ_OFF + (16 * mi + r16) * 272, (32 * ks + 4 * kq) * 2, (32 * ks + 16 + 4 * kq) * 2);
                WS[mi] = MFMA16(fw, Sb[ks], WS[mi]); QS[mi] = MFMA16(fq, Sb[ks], QS[mi]);
            }
#pragma unroll
        for (int mi = 0; mi < 4; ++mi) U[mi] = U[mi] - WS[mi];
        {
            const bf16x8 ub0 = pack2(U[0], U[1]), ub1 = pack2(U[2], U[3]);
            f32x4 O[4];
#pragma unroll
            for (int mi = 0; mi < 4; ++mi) {
                const f32x4 gam = *(const f32x4*)(GGT + 16 * mi + 4 * kq);
                O[mi] = gam * QS[mi];
                O[mi] = MFMA16(ld_pair(smem + GP_OFF + (16 * mi + r16) * 144, (4 * kq) * 2, (16 + 4 * kq) * 2), ub0, O[mi]);
                O[mi] = MFMA16(ld_pair(smem + GP_OFF + (16 * mi + r16) * 144, (32 + 4 * kq) * 2, (48 + 4 * kq) * 2), ub1, O[mi]);
            }
            if (c >= 4) {
#pragma unroll
                for (int mi = 0; mi < 4; ++mi)
#pragma unroll
                    for (int r = 0; r < 4; ++r)
                        OG[((size_t)b * SEQ + 64 * (c - 4) + 16 * mi + 4 * kq + r) * 512 + h * 128 + 16 * wave + r16] = O[mi][r];
            }
        }
        {
            f32x4 Us[4];
#pragma unroll
            for (int mi = 0; mi < 4; ++mi) { const f32x4 dl = *(const f32x4*)(GGT + 64 + 16 * mi + 4 * kq); Us[mi] = U[mi] * dl; }
            const bf16x8 us0 = pack2(Us[0], Us[1]), us1 = pack2(Us[2], Us[3]);
            const float gl = GGT[256];
#pragma unroll
            for (int m = 0; m < 8; ++m) {
                Sacc[m] = Sacc[m] * gl;
                Sacc[m] = MFMA16(ld_pair(smem + GKT_OFF + (16 * m + r16) * 144, (4 * kq) * 2, (16 + 4 * kq) * 2), us0, Sacc[m]);
                Sacc[m] = MFMA16(ld_pair(smem + GKT_OFF + (16 * m + r16) * 144, (32 + 4 * kq) * 2, (48 + 4 * kq) * 2), us1, Sacc[m]);
            }
#pragma unroll
            for (int ks = 0; ks < 4; ++ks) Sb[ks] = pack2(Sacc[2 * ks], Sacc[2 * ks + 1]);
        }
    }
    __syncthreads();
#undef GDN_CHUNK
#undef GDN_PREFETCH
}

DI void phase_gdn_prep(const Params& p) {
    const int lane = threadIdx.x & 63, wave = threadIdx.x >> 6;
    const h16* QKV = (const h16*)(p.ws + WS_QKV);
    const float* GL = (const float*)(p.ws + WS_GL);
    h16* OUT[3] = {(h16*)(p.ws + WS_QC), (h16*)(p.ws + WS_KC), (h16*)(p.ws + WS_VC)};
    float* BETA = (float*)(p.ws + WS_BETA); float* GDEC = (float*)(p.ws + WS_GDEC);
    for (int r = blockIdx.x * 8 + wave; r < NT; r += gridDim.x * 8) {
        const int b = r / TPB, t = r % TPB;
        float acc[3][8];
#pragma unroll
        for (int s = 0; s < 3; ++s)
#pragma unroll
            for (int j = 0; j < 8; ++j) acc[s][j] = 0.f;
        if (t < CTXL) {
            for (int kx = 0; kx < 3; ++kx) {
                const int tt = t + kx - 1;
                if (tt < 0 || tt >= CTXL) continue;
                const size_t rr = (size_t)b * TPB + tt;
#pragma unroll
                for (int s = 0; s < 3; ++s) {
                    const h16x8 v = *(const h16x8*)(QKV + rr * 1536 + s * 512 + lane * 8);
                    const float* w = p.conv_w + (1 * 3 + kx) * 1536 + s * 512 + lane * 8;
#pragma unroll
                    for (int j = 0; j < 8; ++j) acc[s][j] += (float)v[j] * w[j];
                }
            }
        } else {
            const int tl = t - CTXL, gy = tl >> 6, gx = tl & 63;
            for (int ky = 0; ky < 3; ++ky) {
                const int yy = gy + ky - 1;
                if (yy < 0 || yy >= 32) continue;
                for (int kx = 0; kx < 3; ++kx) {
                    const int xx = gx + kx - 1;
                    if (xx < 0 || xx >= 64) continue;
                    const size_t rr = (size_t)b * TPB + CTXL + yy * 64 + xx;
#pragma unroll
                    for (int s = 0; s < 3; ++s) {
                        const h16x8 v = *(const h16x8*)(QKV + rr * 1536 + s * 512 + lane * 8);
                        const float* w = p.conv_w + (ky * 3 + kx) * 1536 + s * 512 + lane * 8;
#pragma unroll
                        for (int j = 0; j < 8; ++j) acc[s][j] += (float)v[j] * w[j];
                    }
                }
            }
        }
#pragma unroll
        for (int s = 0; s < 3; ++s)
#pragma unroll
            for (int j = 0; j < 8; ++j) acc[s][j] = silu_f(acc[s][j]);
#pragma unroll
        for (int s = 0; s < 2; ++s) {
            float ss = 0.f;
#pragma unroll
            for (int j = 0; j < 8; ++j) ss += acc[s][j] * acc[s][j];
            ss += __shfl_xor(ss, 1); ss += __shfl_xor(ss, 2); ss += __shfl_xor(ss, 4); ss += __shfl_xor(ss, 8);
            const float sc = rsqrtf(ss + 1e-6f) * (s == 0 ? 0.08838834764831845f : 1.0f);
#pragma unroll
            for (int j = 0; j < 8; ++j) acc[s][j] *= sc;
        }
#pragma unroll
        for (int s = 0; s < 3; ++s) {
            h16x8 o;
#pragma unroll
            for (int j = 0; j < 8; ++j) o[j] = (h16)acc[s][j];
            *(h16x8*)(OUT[s] + (size_t)r * 512 + lane * 8) = o;
        }
        if (lane < 8) {
            const float bl = GL[(size_t)r * 16 + lane], al = GL[(size_t)r * 16 + 8 + lane];
            BETA[(size_t)r * 8 + lane] = sigmoid_f(bl);
            GDEC[(size_t)r * 8 + lane] = -expf(p.a_log[lane]) * softplus_f(al + p.dt_bias[lane]);
        }
    }
}

DI int seq_row(int dir, int pos) { return dir == 0 ? pos : (pos < CTXL ? (CTXL - 1 - pos) : (TPB + CTXL - 1 - pos)); }

DI void gdn_naive_block(const Params& p, float* lds, int blk) {
    const int tid = threadIdx.x, slot = tid >> 8, half = (tid >> 7) & 1, j = tid & 127;
    const int unit = blk * 2 + slot, b = unit >> 3, h = (unit >> 1) & 3, dir = unit & 1;
    const h16* QC = (const h16*)(p.ws + WS_QC); const h16* KC = (const h16*)(p.ws + WS_KC); const h16* VC = (const h16*)(p.ws + WS_VC);
    const float* BETA = (const float*)(p.ws + WS_BETA); const float* GDEC = (const float*)(p.ws + WS_GDEC);
    float* OG = p.out + (size_t)dir * NL * 512;
    float* kq = lds + slot * (8 * 2 * 128);
    float* xk = lds + 2 * (8 * 2 * 128) + slot * 256;
    float* xo = xk + 512;
    float S[64];
#pragma unroll
    for (int i = 0; i < 64; ++i) S[i] = 0.f;
    for (int pos0 = 0; pos0 < TPB; pos0 += 8) {
#pragma unroll
        for (int e = 0; e < 8; ++e) {
            const int idx = e * 256 + (tid & 255), tok = idx >> 8, which = (idx >> 7) & 1, d = idx & 127;
            const size_t r = (size_t)b * TPB + seq_row(dir, pos0 + tok);
            kq[idx] = (float)((which ? QC : KC)[r * 512 + h * 128 + d]);
        }
        __syncthreads();
        for (int tok = 0; tok < 8; ++tok) {
            const int t = seq_row(dir, pos0 + tok);
            const size_t r = (size_t)b * TPB + t;
            const float bt = BETA[r * 8 + dir * 4 + h], a = __expf(GDEC[r * 8 + dir * 4 + h]);
            const float v = (float)VC[r * 512 + h * 128 + j];
            const float* kk = kq + tok * 256 + half * 64; const float* qq = kk + 128;
            float ks = 0.f;
#pragma unroll
            for (int i = 0; i < 64; i += 4) { const f32x4 k4 = *(const f32x4*)(kk + i); ks += k4[0] * S[i] + k4[1] * S[i + 1] + k4[2] * S[i + 2] + k4[3] * S[i + 3]; }
            xk[half * 128 + j] = ks;
            __syncthreads();
            ks += xk[(1 - half) * 128 + j];
            const float cc = bt * (v - a * ks);
            float o = 0.f;
#pragma unroll
            for (int i = 0; i < 64; i += 4) {
                const f32x4 k4 = *(const f32x4*)(kk + i), q4 = *(const f32x4*)(qq + i);
                S[i] = a * S[i] + k4[0] * cc; S[i + 1] = a * S[i + 1] + k4[1] * cc; S[i + 2] = a * S[i + 2] + k4[2] * cc; S[i + 3] = a * S[i + 3] + k4[3] * cc;
                o += q4[0] * S[i] + q4[1] * S[i + 1] + q4[2] * S[i + 2] + q4[3] * S[i + 3];
            }
            xo[half * 128 + j] = o;
            __syncthreads();
            if (half == 0 && t >= CTXL) OG[((size_t)b * SEQ + (t - CTXL)) * 512 + h * 128 + j] = o + xo[128 + j];
        }
        __syncthreads();
    }
}

DI void s5_naive_wave(const Params& p, float* ubuf  , int u) {
    const int lane = threadIdx.x & 63, b = u >> 5, g = u & 31, pidx = lane;
    const h16* UG = (const h16*)(p.ws + WS_UG) + ((size_t)b * 32 + g) * TPB * 16;
    float* YS5 = (float*)(p.ws + WS_YS5); h16* G = (h16*)(p.ws + WS_G);
    for (int dir = 0; dir < 2; ++dir) {
        const int dg = dir * 32 + g;
        const double lre = p.lre[dg * 64 + pidx], lim = p.lim[dg * 64 + pidx], dt = (double)expf(p.logdt[dg]);
        double ang = lim * dt; ang -= 6.283185307179586477 * rint(ang * 0.15915494309189533577);
        float sn, cs; sincosf((float)ang, &sn, &cs);
        const double er = (double)expf((float)(lre * dt)), ar_d = er * (double)cs, ai_d = er * (double)sn;
        const double nr = ar_d - 1.0, ni = ai_d, den = lre * lre + lim * lim;
        const float cfr = (float)((nr * lre + ni * lim) / den), cfi = (float)((ni * lre - nr * lim) / den);
        const float ar = (float)ar_d, ai = (float)ai_d;
        float bbr[16], bbi[16], ccr[16], cci[16];
#pragma unroll
        for (int c = 0; c < 16; ++c) {
            const float br = p.bre[((size_t)dg * 64 + pidx) * 16 + c], bi = p.bim[((size_t)dg * 64 + pidx) * 16 + c];
            bbr[c] = cfr * br - cfi * bi; bbi[c] = cfr * bi + cfi * br;
            ccr[c] = p.cre[((size_t)dg * 16 + c) * 64 + pidx]; cci[c] = p.cim[((size_t)dg * 16 + c) * 64 + pidx];
        }
        float hr = 0.f, hi = 0.f;
        for (int pos0 = 0; pos0 < TPB; pos0 += 64) {
            {
                const int t = seq_row(dir, pos0 + lane);
                const h16x8 v0 = *(const h16x8*)(UG + (size_t)t * 16), v1 = *(const h16x8*)(UG + (size_t)t * 16 + 8);
#pragma unroll
                for (int c = 0; c < 8; ++c) { ubuf[lane * 16 + c] = (float)v0[c]; ubuf[lane * 16 + 8 + c] = (float)v1[c]; }
            }
            asm volatile("s_waitcnt lgkmcnt(0)" ::: "memory");
            for (int tk = 0; tk < 64; ++tk) {
                const int t = seq_row(dir, pos0 + tk);
                float uu[16];
#pragma unroll
                for (int c = 0; c < 16; c += 4) { const f32x4 q = *(const f32x4*)(ubuf + tk * 16 + c); uu[c] = q[0]; uu[c + 1] = q[1]; uu[c + 2] = q[2]; uu[c + 3] = q[3]; }
                float sr = 0.f, si = 0.f;
#pragma unroll
                for (int c = 0; c < 16; ++c) { sr += bbr[c] * uu[c]; si += bbi[c] * uu[c]; }
                const float nhr = ar * hr - ai * hi + sr, nhi = ar * hi + ai * hr + si;
                hr = nhr; hi = nhi;
                if (t >= CTXL) {
                    float v[16];
#pragma unroll
                    for (int c = 0; c < 16; ++c) v[c] = ccr[c] * hr - cci[c] * hi;
                    const bool b5 = (lane >> 5) & 1, b4 = (lane >> 4) & 1, b3 = (lane >> 3) & 1, b2 = (lane >> 2) & 1;
                    float w8[8], w4[4], w2[2], w1;
#pragma unroll
                    for (int i = 0; i < 8; ++i) { const float keep = b5 ? v[8 + i] : v[i], send = b5 ? v[i] : v[8 + i]; w8[i] = keep + __shfl_xor(send, 32); }
#pragma unroll
                    for (int i = 0; i < 4; ++i) { const float keep = b4 ? w8[4 + i] : w8[i], send = b4 ? w8[i] : w8[4 + i]; w4[i] = keep + __shfl_xor(send, 16); }
#pragma unroll
                    for (int i = 0; i < 2; ++i) { const float keep = b3 ? w4[2 + i] : w4[i], send = b3 ? w4[i] : w4[2 + i]; w2[i] = keep + __shfl_xor(send, 8); }
                    { const float keep = b2 ? w2[1] : w2[0], send = b2 ? w2[0] : w2[1]; w1 = keep + __shfl_xor(send, 4); }
                    w1 += __shfl_xor(w1, 2); w1 += __shfl_xor(w1, 1);
                    if ((lane & 3) == 0) {
                        const int c = lane >> 2;
                        const size_t o = ((size_t)b * SEQ + (t - CTXL)) * 512 + g * 16 + c;
                        if (dir == 0) YS5[o] = p.s5d[g * 16 + c] * ubuf[tk * 16 + c] + w1;
                        else G[o] = (h16)gelu_f(YS5[o] + w1);
                    }
                }
            }
            asm volatile("s_waitcnt lgkmcnt(0)" ::: "memory");
        }
    }
}

DI void phase_seq(const Params& p, float* lds) {
#if GDN_NAIVE
    if ((int)blockIdx.x < 64) { gdn_naive_block(p, lds, blockIdx.x); return; }
    for (int u = (int)blockIdx.x - 64; u < 512; u += (int)gridDim.x - 64) s5_unit(p, (unsigned char*)lds, u);
#else
    if ((int)blockIdx.x < 128) { gdn_unit(p, (unsigned char*)lds, blockIdx.x); return; }
    for (int u = (int)blockIdx.x - 128; u < 512; u += (int)gridDim.x - 128) s5_unit(p, (unsigned char*)lds, u);
#endif
}

DI void phase_mix(const Params& p, PG8_LAS unsigned char* ldsp) {
    {
        pg8::Gemm g{(const bf16_t*)(p.ws + WS_G), (const bf16_t*)(p.ws + WS_WGLUT), NL, 512, 512};
        pg8::StaticOrder S; S.init(NL, 512, (int)gridDim.x, (int)blockIdx.x);
        EpiGluMK E{(const bf16_t*)(p.ws + WS_G), (const bf16_t*)(p.ws + WS_ZS), p.b_glu, (bf16_t*)(p.ws + WS_MIX)};
        pg8::gemm_phase(ldsp, g, S, E);
    }
    const int lane = threadIdx.x & 63, wave = threadIdx.x >> 6;
    const float* OGF = p.out; const float* OGR = p.out + (size_t)NL * 512;
    const h16* ZG = (const h16*)(p.ws + WS_ZG); h16* MIX = (h16*)(p.ws + WS_MIX);
    for (int r = blockIdx.x * 8 + wave; r < NL; r += gridDim.x * 8) {
        const int b = r / SEQ, tl = r % SEQ; const size_t rnt = (size_t)b * TPB + CTXL + tl;
        float o[8]; float ss = 0.f;
#pragma unroll
        for (int j = 0; j < 8; ++j) { o[j] = OGF[(size_t)r * 512 + lane * 8 + j] + OGR[(size_t)r * 512 + lane * 8 + j]; ss += o[j] * o[j]; }
        ss += __shfl_xor(ss, 1); ss += __shfl_xor(ss, 2); ss += __shfl_xor(ss, 4); ss += __shfl_xor(ss, 8);
        const float rs = rsqrtf(ss * (1.f / 128.f) + 1e-6f);
        const h16x8 z = *(const h16x8*)(ZG + rnt * 512 + lane * 8);
        h16x8 ov;
#pragma unroll
        for (int j = 0; j < 8; ++j) ov[j] = (h16)(o[j] * rs * p.norm_w[(lane * 8 + j) & 127] * silu_f((float)z[j]));
        *(h16x8*)(MIX + (size_t)r * 1024 + 512 + lane * 8) = ov;
    }
}

DI void phase_out(const Params& p, PG8_LAS unsigned char* ldsp) {
    pg8::Gemm g{(const bf16_t*)(p.ws + WS_MIX), (const bf16_t*)(p.ws + WS_WOUTT), NL, 1024, 1024};
    pg8::StaticOrder S; S.init(NL, 1024, (int)gridDim.x, (int)blockIdx.x);
    pg8::EpiF32 E{(float*)(p.ws + WS_Y), 1024, nullptr};
    pg8::gemm_phase(ldsp, g, S, E);
}
DI void phase_inproj(const Params& p, PG8_LAS unsigned char* ldsp) {
    pg8::Gemm g{(const bf16_t*)(p.ws + WS_HB), (const bf16_t*)(p.ws + WS_WINT), NT, NIN_PAD, DM};
    pg8::StaticOrder S; S.init(NT, NIN_PAD, (int)gridDim.x, (int)blockIdx.x);
    EpiInprojMK E{(bf16_t*)(p.ws + WS_UG), (bf16_t*)(p.ws + WS_ZS), (bf16_t*)(p.ws + WS_QKV), (bf16_t*)(p.ws + WS_ZG), (float*)(p.ws + WS_GL)};
    pg8::gemm_phase(ldsp, g, S, E);
}

DI void phase_ln(const Params& p) {
    const int lane = threadIdx.x & 63, wave = threadIdx.x >> 6;
    const float* ADA = (const float*)(p.ws + WS_ADA); const float* Y = (const float*)(p.ws + WS_Y);
    for (int r = blockIdx.x * 8 + wave; r < NL; r += gridDim.x * 8) {
        const int b = r / SEQ;
        f32x4 v[4]; float s = 0.f;
#pragma unroll
        for (int j = 0; j < 4; ++j) {
            const int k = j * 256 + lane * 4;
            const f32x4 xv = *(const f32x4*)(p.x + (size_t)r * DM + k), yv = *(const f32x4*)(Y + (size_t)r * DM + k), gt = *(const f32x4*)(ADA + b * 3072 + 2048 + k);
            v[j] = xv * DN_ALPHA + gt * yv;
            s += (v[j][0] + v[j][1]) + (v[j][2] + v[j][3]);
        }
#pragma unroll
        for (int o = 1; o < 64; o <<= 1) s += __shfl_xor(s, o);
        const float mean = s * (1.f / DM); float q = 0.f;
#pragma unroll
        for (int j = 0; j < 4; ++j) { v[j] = v[j] - mean; q += (v[j][0] * v[j][0] + v[j][1] * v[j][1]) + (v[j][2] * v[j][2] + v[j][3] * v[j][3]); }
#pragma unroll
        for (int o = 1; o < 64; o <<= 1) q += __shfl_xor(q, o);
        const float rstd = rsqrtf(q * (1.f / DM) + 1e-5f);
#pragma unroll
        for (int j = 0; j < 4; ++j) {
            const int k = j * 256 + lane * 4;
            const f32x4 gg = *(const f32x4*)(p.ln_g + k), bb = *(const f32x4*)(p.ln_b + k);
            *(f32x4*)(p.out + (size_t)r * DM + k) = v[j] * rstd * gg + bb;
        }
    }
}

constexpr int NPHASE = 8;
constexpr int LDS_BYTES = 163840;

#if defined(__HIP_DEVICE_COMPILE__)
typedef const __attribute__((address_space(4))) Params* KParamsPtr;
DI Params load_params() { KParamsPtr kp = (KParamsPtr)__builtin_amdgcn_kernarg_segment_ptr(); asm volatile("" : "+s"(kp)); Params q; __builtin_memcpy(&q, kp, sizeof(Params)); return q; }
#else
DI Params load_params() { return Params{}; }
#endif

template <bool COOP>
__global__ void __launch_bounds__(NTHR, 2) mega(Params p_unused, int ph_lo, int ph_hi) {
    extern __shared__ __attribute__((aligned(16))) unsigned char smem[];
    float* lds = (float*)smem;
    PG8_LAS unsigned char* ldsp = (PG8_LAS unsigned char*)smem;
#ifndef ONLY_PHASE
#define ONLY_PHASE -1
#endif
#define PH_IN(k) (ph_lo <= (k) && (k) < ph_hi && (ONLY_PHASE < 0 || ONLY_PHASE == (k)))
#define PH_SYNC(k) do { if (COOP && PH_IN(k) && PH_IN((k) + 1)) cg::this_grid().sync(); } while (0)
    if (PH_IN(0)) { const Params p = load_params(); phase_ada(p, lds); if ((int)blockIdx.x >= 48 && (int)blockIdx.x < 80) s5_build_tables(p, lds, (int)blockIdx.x - 48); __syncthreads(); phase_weights(p, lds); }
    PH_SYNC(0);
    if (PH_IN(1)) { const Params p = load_params(); phase_modulate(p); }
    PH_SYNC(1);
    if (PH_IN(2)) { const Params p = load_params(); phase_inproj(p, ldsp); }
    PH_SYNC(2);
    if (PH_IN(3)) { const Params p = load_params(); phase_gdn_local(p, smem); }
    PH_SYNC(3);
    if (PH_IN(4)) { const Params p = load_params(); phase_seq(p, lds); }
    PH_SYNC(4);
    if (PH_IN(5)) { const Params p = load_params(); phase_mix(p, ldsp); }
    PH_SYNC(5);
    if (PH_IN(6)) { const Params p = load_params(); phase_out(p, ldsp); }
    PH_SYNC(6);
    if (PH_IN(7)) { const Params p = load_params(); phase_ln(p); }
}

extern "C" void kernel_launch(void* const* d_in, const int* in_sizes, int n_in, void* d_out, int out_size, void* d_ws, size_t ws_size,
                              hipStream_t stream) {
    static int grid = 0;
    if (grid == 0) {
        if (n_in != 24 || ws_size < WS_END) { fprintf(stderr, "kernel_launch: unexpected n_in %d / ws_size %zu\n", n_in, ws_size); grid = -1; return; }
        int dev = 0, cus = 0;
        hipGetDevice(&dev);
        hipDeviceGetAttribute(&cus, hipDeviceAttributeMultiprocessorCount, dev);
        hipFuncSetAttribute((const void*)mega<true>, hipFuncAttributeMaxDynamicSharedMemorySize, LDS_BYTES);
        hipFuncSetAttribute((const void*)mega<false>, hipFuncAttributeMaxDynamicSharedMemorySize, LDS_BYTES);
        int per_cu = 0;
        hipOccupancyMaxActiveBlocksPerMultiprocessor(&per_cu, (const void*)mega<true>, NTHR, LDS_BYTES);
        if (per_cu < 1) fprintf(stderr, "kernel_launch: occupancy query says %d blocks/CU\n", per_cu);
        (void)hipGetLastError();
        grid = cus > 0 ? cus : 256;
    }
    if (grid < 0) return;
    Params p{};
    const float** pp = (const float**)&p;
    for (int i = 0; i < 24; ++i) pp[i] = (const float*)d_in[i];
    p.out = (float*)d_out; p.ws = (unsigned char*)d_ws;
#if MK_ONE_LAUNCH
    int lo = 0, hi = NPHASE;
    void* args[] = {&p, &lo, &hi};
    hipError_t e = hipLaunchCooperativeKernel((const void*)mega<true>, dim3(grid), dim3(NTHR), args, LDS_BYTES, stream);
    if (e != hipSuccess) fprintf(stderr, "cooperative launch failed: %s (grid %d)\n", hipGetErrorString(e), grid);
#else
    for (int ph = 0; ph < NPHASE; ++ph) hipLaunchKernelGGL(mega<false>, dim3(grid), dim3(NTHR), LDS_BYTES, stream, p, ph, ph + 1);
#endif
}
```

```cpp
#include <hip/hip_runtime.h>
#include <hip/hip_cooperative_groups.h>
#include <cstdio>
#include <cstdint>
namespace cg = cooperative_groups;

#ifndef DUP_SUB
#define DUP_SUB 0
#endif
#ifndef DUP_PHASE
#define DUP_PHASE -1
#endif
#ifndef GDN_NAIVE
#define GDN_NAIVE 0
#endif
#ifndef MK_ONE_LAUNCH
#define MK_ONE_LAUNCH 1
#endif

typedef __bf16 h16;
typedef __bf16 h16x4 __attribute__((ext_vector_type(4)));
typedef __bf16 h16x8 __attribute__((ext_vector_type(8)));
typedef float f32x4 __attribute__((ext_vector_type(4)));
#define DI __device__ __forceinline__

constexpr int DM = 1024, NB = 16, SEQ = 2048, CTXL = 256, TPB = CTXL + SEQ  ;
constexpr int NT = NB * TPB  , NL = NB * SEQ  ;
constexpr int PIN = 3088;
constexpr int NTHR = 512;
constexpr float DN_ALPHA = 1.189207115002721f;

constexpr size_t MiB = 1u << 20;
constexpr size_t WS_CTL = 0, WS_ADA = 1 * MiB;
constexpr size_t WS_WINT = 2 * MiB  , WS_WOUTT = 10 * MiB  , WS_WGLUT = 12 * MiB  ;
constexpr size_t WS_HB = 252 * MiB  ;
constexpr int NIN_PAD = 3328;
constexpr size_t WS_TAB = 14 * MiB;
constexpr size_t WS_A16 = 26 * MiB;
constexpr size_t TAB_G_BYTES = 393216;
constexpr size_t WS_UG = 32 * MiB, WS_ZS = 68 * MiB, WS_QKV = 104 * MiB, WS_ZG = 212 * MiB, WS_GL = 248 * MiB;
constexpr size_t WS_QC = 252 * MiB  , WS_KT = 104 * MiB  , WS_VT = 140 * MiB, WS_BETA = 360 * MiB, WS_GDEC = 362 * MiB;
constexpr size_t WS_KC = 288 * MiB, WS_VC = 324 * MiB;
constexpr size_t WS_LOC = 364 * MiB;
constexpr size_t LOC_BYTES = 20480;
constexpr size_t WS_YS5 = 364 * MiB, WS_G = 456 * MiB, WS_MIX = 252 * MiB  , WS_Y = 364 * MiB, WS_END = 512 * MiB;

struct Params {
    const float *x, *c, *ctx, *c_ctx, *w_ada, *b_ada, *w_in, *lre, *lim, *logdt, *bre, *bim, *cre, *cim, *s5d,
        *w_glu, *b_glu, *conv_w, *a_log, *dt_bias, *norm_w, *w_out, *ln_g, *ln_b;
    float* out;
    unsigned char* ws;
};

DI float silu_f(float v) { return v / (1.f + __expf(-v)); }
DI float sigmoid_f(float v) { return 1.f / (1.f + __expf(-v)); }
DI float gelu_f(float v) { return 0.5f * v * (1.f + erff(v * 0.70710678118654752f)); }
DI float softplus_f(float v) { return v > 20.f ? v : log1pf(expf(v)); }

DI void phase_ada(const Params& p, float* lds) {
    const int tid = threadIdx.x;
    if ((int)blockIdx.x >= 48) return;
    float* sc = lds;
    float* red = lds + 17 * 1024;
    float* ADA = (float*)(p.ws + WS_ADA);
    for (int i = tid; i < 17 * 1024; i += NTHR) {
        const int r = i >> 10, k = i & 1023;
        const float v = r < 16 ? p.c[r * 1024 + k] : p.c_ctx[k];
        sc[i] = silu_f(v);
    }
    __syncthreads();
    for (int unit = blockIdx.x; unit < 48; unit += gridDim.x) {
        const int ks = tid >> 6, col = tid & 63, n = unit * 64 + col;
#define ADA_ROWS(X) X(0) X(1) X(2) X(3) X(4) X(5) X(6) X(7) X(8) X(9) X(10) X(11) X(12) X(13) X(14) X(15) X(16)
#define ADA_DECL(r) float acc##r = 0.f;
#define ADA_FMA(r) acc##r += sc[(r) * 1024 + k] * w;
#define ADA_PUT(r) red[(ks * 17 + (r)) * 64 + col] = acc##r;
        ADA_ROWS(ADA_DECL)
        for (int k = ks * 128; k < ks * 128 + 128; ++k) {
            const float w = p.w_ada[(size_t)k * 3072 + n];
            ADA_ROWS(ADA_FMA)
        }
        ADA_ROWS(ADA_PUT)
#undef ADA_DECL
#undef ADA_FMA
#undef ADA_PUT
#undef ADA_ROWS
        __syncthreads();
        for (int i = tid; i < 17 * 64; i += NTHR) {
            const int r = i >> 6, cc = i & 63;
            float s = p.b_ada[unit * 64 + cc];
#pragma unroll
            for (int q = 0; q < 8; ++q) s += red[(q * 17 + r) * 64 + cc];
            ADA[r * 3072 + unit * 64 + cc] = s;
        }
        __syncthreads();
    }
}

template <class AL, class BL, class EP>
DI void gemm_naive(int N, int K, int ntm, int ntn, const AL& al, const BL& bl, const EP& ep, float* lds) {
    const int tid = threadIdx.x, ty = tid >> 5, tx = tid & 31;
    float* As = lds;
    float* Bs = lds + 16 * 132;
    for (int tile = blockIdx.x; tile < ntm * ntn; tile += gridDim.x) {
        const int tm = tile / ntn, tn = tile % ntn;
        f32x4 acc[8];
#pragma unroll
        for (int i = 0; i < 8; ++i) acc[i] = (f32x4){0.f, 0.f, 0.f, 0.f};
        const int arow = tm * 128 + (tid >> 2), akk = (tid & 3) * 4;
        const int bk = tid >> 5, bcol = tn * 128 + (tid & 31) * 4;
#pragma unroll 1
        for (int k0 = 0; k0 < K; k0 += 16) {
            const f32x4 a = al(arow, k0 + akk);
            f32x4 b = (f32x4){0.f, 0.f, 0.f, 0.f};
            if (bcol < N) b = bl(k0 + bk, bcol);
            __syncthreads();
#pragma unroll
            for (int j = 0; j < 4; ++j) As[(akk + j) * 132 + (tid >> 2)] = a[j];
            *(f32x4*)(Bs + bk * 128 + (tid & 31) * 4) = b;
            __syncthreads();
#pragma unroll
            for (int k = 0; k < 16; ++k) {
                const f32x4 a0 = *(const f32x4*)(As + k * 132 + ty * 8), a1 = *(const f32x4*)(As + k * 132 + ty * 8 + 4);
                const f32x4 bv = *(const f32x4*)(Bs + k * 128 + tx * 4);
                acc[0] += bv * a0[0]; acc[1] += bv * a0[1]; acc[2] += bv * a0[2]; acc[3] += bv * a0[3];
                acc[4] += bv * a1[0]; acc[5] += bv * a1[1]; acc[6] += bv * a1[2]; acc[7] += bv * a1[3];
            }
        }
        ep(tm * 128 + ty * 8, tn * 128 + tx * 4, acc);
    }
}

struct BLoadF32 {
    const float* w; int N;
    DI f32x4 operator()(int k, int col) const { return *(const f32x4*)(w + (size_t)k * N + col); }
};
struct ALoadF16 {
    const h16* a; int lda;
    DI f32x4 operator()(int row, int k) const {
        const h16x4 v = *(const h16x4*)(a + (size_t)row * lda + k);
        return (f32x4){(float)v[0], (float)v[1], (float)v[2], (float)v[3]};
    }
};
struct ALoadInproj {
    const float *x, *ctx, *ADA;
    DI f32x4 operator()(int row, int k) const {
        const int b = row / TPB, t = row % TPB;
        const float* src = t < CTXL ? ctx + ((size_t)b * CTXL + t) * DM : x + ((size_t)b * SEQ + (t - CTXL)) * DM;
        const int cr = t < CTXL ? 16 : b;
        const f32x4 v = *(const f32x4*)(src + k);
        const f32x4 sh = *(const f32x4*)(ADA + cr * 3072 + k), sc = *(const f32x4*)(ADA + cr * 3072 + 1024 + k);
        return v * (sc + 1.0f) + sh;
    }
};
DI h16x4 to_h4(const f32x4 a) { return (h16x4){(h16)a[0], (h16)a[1], (h16)a[2], (h16)a[3]}; }
struct EpiInproj {
    h16 *UG, *ZS, *QKV, *ZG; float* GL;
    DI void operator()(int r0, int c0, const f32x4 (&acc)[8]) const {
        if (c0 >= PIN) return;
#pragma unroll
        for (int i = 0; i < 8; ++i) {
            const int row = r0 + i, b = row / TPB, t = row % TPB;
            if (c0 < 512) *(h16x4*)(UG + (((size_t)b * 32 + (c0 >> 4)) * TPB + t) * 16 + (c0 & 15)) = to_h4(acc[i]);
            else if (c0 < 1024) *(h16x4*)(ZS + (size_t)row * 512 + (c0 - 512)) = to_h4(acc[i]);
            else if (c0 < 2560) *(h16x4*)(QKV + (size_t)row * 1536 + (c0 - 1024)) = to_h4(acc[i]);
            else if (c0 < 3072) *(h16x4*)(ZG + (size_t)row * 512 + (c0 - 2560)) = to_h4(acc[i]);
            else *(f32x4*)(GL + (size_t)row * 16 + (c0 - 3072)) = acc[i];
        }
    }
};
struct EpiGlu {
    const h16 *G, *ZS; const float* b_glu; h16* MIX;
    DI void operator()(int r0, int c0, const f32x4 (&acc)[8]) const {
#pragma unroll
        for (int i = 0; i < 8; ++i) {
            const int r = r0 + i, b = r / SEQ, tl = r % SEQ;
            const size_t rnt = (size_t)b * TPB + CTXL + tl;
            const h16x4 g = *(const h16x4*)(G + (size_t)r * 512 + c0), z = *(const h16x4*)(ZS + rnt * 512 + c0);
            f32x4 o;
#pragma unroll
            for (int j = 0; j < 4; ++j) o[j] = (float)g[j] * sigmoid_f(acc[i][j] + b_glu[c0 + j]) * silu_f((float)z[j]);
            *(h16x4*)(MIX + (size_t)r * 1024 + c0) = to_h4(o);
        }
    }
};
struct EpiF32Out {
    float* Y; int ldc;
    DI void operator()(int r0, int c0, const f32x4 (&acc)[8]) const {
#pragma unroll
        for (int i = 0; i < 8; ++i) *(f32x4*)(Y + (size_t)(r0 + i) * ldc + c0) = acc[i];
    }
};

DI void phase_inproj_naive(const Params& p, float* lds) {
    ALoadInproj al{p.x, p.ctx, (const float*)(p.ws + WS_ADA)};
    BLoadF32 bl{p.w_in, PIN};
    EpiInproj ep{(h16*)(p.ws + WS_UG), (h16*)(p.ws + WS_ZS), (h16*)(p.ws + WS_QKV), (h16*)(p.ws + WS_ZG), (float*)(p.ws + WS_GL)};
    gemm_naive(PIN, DM, NT / 128, (PIN + 127) / 128, al, bl, ep, lds);
}

namespace pg8 {
#define PG8_LAS __attribute__((address_space(3)))
typedef unsigned short bf16_t;
typedef short bf16x8 __attribute__((ext_vector_type(8)));
typedef float f32x4 __attribute__((ext_vector_type(4)));
typedef unsigned u32x4 __attribute__((ext_vector_type(4)));
constexpr int BM = 256, BK = 64, HALF = 128, HTB = HALF * BK * 2  , STAGE_BYTES = 8 * HTB, NXCD = 8, WGM = 8;

__host__ __device__ __forceinline__ int lds_byte(int r, int c) { const int st = (r >> 4) * 2 + (c >> 5), rr = r & 15, cc = c & 31, ob = rr * 64 + cc * 2; return st * 1024 + (ob ^ (((ob >> 9) & 1) << 5)); }
__host__ __device__ __forceinline__ void stage_rc(int b, int& R, int& C) { const int st = b / 1024, sb = b % 1024, swz = sb ^ (((sb >> 9) & 1) << 5); R = (st >> 1) * 16 + swz / 64; C = (st & 1) * 32 + (swz % 64) / 2; }
__host__ __device__ __forceinline__ int perm32(int rho) { const int n = rho >> 4, i = rho & 15; return 8 * (i >> 2) + 4 * n + (i & 3); }

struct Unit { int pm, pn; };
struct Gemm { const bf16_t* A; const bf16_t* Bt; int M, N, K; };

struct StaticOrder {
    int nM, nN, nwg, G, c;
    __host__ __device__ void init(int M, int N, int G_, int c_) { nM = M / BM; nN = N / BM; nwg = nM * nN; G = G_; c = c_; }
    __host__ __device__ bool next(int i, Unit& u) const {
        const long L = (long)i * G + c; if (L >= nwg) return false;
        int wgid = (int)L; { const int q = nwg / NXCD, r = nwg % NXCD, xcd = wgid % NXCD, off = wgid / NXCD; wgid = (xcd < r ? xcd * (q + 1) : r * (q + 1) + (xcd - r) * q) + off; }
        const int nig = WGM * nN, gid = wgid / nig, fm = gid * WGM, gsz = (nM - fm) < WGM ? (nM - fm) : WGM;
        u.pm = fm + ((wgid % nig) % gsz); u.pn = (wgid % nig) / gsz; return true;
    }
    __device__ __forceinline__ void a_ready(const Unit&) const {}
    __device__ __forceinline__ void done(const Unit&) const {}
};
__device__ __forceinline__ unsigned cvt_pk_bf16(float lo, float hi) { typedef __bf16 bf16v2_ __attribute__((ext_vector_type(2))); const bf16v2_ v = {(__bf16)lo, (__bf16)hi}; return __builtin_bit_cast(unsigned, v); }
typedef float f32x2 __attribute__((ext_vector_type(2)));
__device__ __forceinline__ f32x2 gelu_pk(f32x2 v) {
    const f32x2 av = __builtin_elementwise_abs(v), d = av * 0.2316418882f + 1.0f;
    f32x2 t; t.x = __builtin_amdgcn_rcpf(d.x); t.y = __builtin_amdgcn_rcpf(d.y);
    f32x2 q = t * 0.5307027145f + (-0.7265760135f); q = q * t + 0.7107068705f; q = q * t + (-0.142248368f); q = q * t + 0.127414796f; q = q * t;
    const f32x2 s = (v * v) * (-0.72134752044f);
    f32x2 e; e.x = __builtin_amdgcn_exp2f(s.x); e.y = __builtin_amdgcn_exp2f(s.y);
    const f32x2 m = v * (q * e), r = v - m;
    f32x2 o; o.x = v.x < 0.f ? m.x : r.x; o.y = v.y < 0.f ? m.y : r.y; return o;
}

struct EpiF32 {
    static constexpr bool PERM = false, AFTER_DRAIN = false;
    float* C; int ldc; const float* bias;
    __device__ __forceinline__ void operator()(const f32x4 (&acc)[2][2][4][2], const Unit& u, int wr, int wc, int fr, int fq) const {
        const int row0 = u.pm * BM + wr * 64 + fr, col0 = u.pn * BM + wc * 32 + 4 * fq;
        f32x4 bv[2][2];
#pragma unroll
        for (int bj = 0; bj < 2; ++bj)
#pragma unroll
            for (int n = 0; n < 2; ++n) bv[bj][n] = bias ? *(const f32x4*)(bias + col0 + bj * HALF + n * 16) : (f32x4){0.f, 0.f, 0.f, 0.f};
#pragma unroll
        for (int ai = 0; ai < 2; ++ai)
#pragma unroll
            for (int m = 0; m < 4; ++m) { float* rowp = C + (size_t)(row0 + ai * HALF + m * 16) * ldc + col0;
#pragma unroll
                for (int bj = 0; bj < 2; ++bj)
#pragma unroll
                    for (int n = 0; n < 2; ++n) *(f32x4*)(rowp + bj * HALF + n * 16) = acc[ai][bj][m][n] + bv[bj][n]; }
    }
};
template <class Epi, class Sched>
__device__ __forceinline__ void gemm_phase(PG8_LAS unsigned char* lds, const Gemm g, const Sched& S, const Epi& E) {
    const int tid = threadIdx.x, wid = __builtin_amdgcn_readfirstlane(tid >> 6), lane = tid & 63, wr = wid >> 2, wc = wid & 3, fr = lane & 15, fq = lane >> 4;
    const int K = g.K, nt = K / BK;
    unsigned voffA[2], voffB[2];
#pragma unroll
    for (int i = 0; i < 2; ++i) { int R, C; stage_rc(tid * 16 + i * 8192, R, C); const int Rb = Epi::PERM ? ((R & ~31) + perm32(R & 31)) : R;
        voffA[i] = (unsigned)(R * K + C) * 2u; voffB[i] = (unsigned)(Rb * K + C) * 2u; }
    const size_t kstep = (size_t)(BK * 2);
    const size_t hstep = (size_t)HALF * K * 2;
    const size_t tstep = 2 * hstep;
    const unsigned ldsw = (unsigned)wid * 1024u;
    const int aoff = lds_byte(wr * 64 + fr, fq * 8), boff = lds_byte(wc * 32 + fr, fq * 8);
#define PG8_SA(b, h) (((b) * 2 + (h)) * HTB)
#define PG8_SB(b, h) ((4 + (b) * 2 + (h)) * HTB)
#define PG8_STAGE(bufoff, gbase, voff) do { _Pragma("unroll") for (int _i = 0; _i < 2; ++_i) \
        __builtin_amdgcn_global_load_lds((const unsigned*)((const char*)(gbase) + (voff)[_i]), (PG8_LAS unsigned*)(lds + (bufoff) + ldsw + _i * 8192), 16, 0, 0); } while (0)
#define PG8_LDA(dst, b, h) do { _Pragma("unroll") for (int m = 0; m < 4; ++m) _Pragma("unroll") for (int k = 0; k < 2; ++k) dst[m][k] = *(const PG8_LAS bf16x8*)(lds + PG8_SA(b, h) + aoff + m * 2048 + k * 1024); } while (0)
#define PG8_LDB(dst, b, h) do { _Pragma("unroll") for (int n = 0; n < 2; ++n) _Pragma("unroll") for (int k = 0; k < 2; ++k) dst[n][k] = *(const PG8_LAS bf16x8*)(lds + PG8_SB(b, h) + boff + n * 2048 + k * 1024); } while (0)
#define PG8_MMA(ai, bj, At, Bt) do { __builtin_amdgcn_s_setprio(1); _Pragma("unroll") for (int m = 0; m < 4; ++m) _Pragma("unroll") for (int n = 0; n < 2; ++n) _Pragma("unroll") for (int k = 0; k < 2; ++k) \
        acc[ai][bj][m][n] = __builtin_amdgcn_mfma_f32_16x16x32_bf16(Bt[n][k], At[m][k], acc[ai][bj][m][n], 0, 0, 0); __builtin_amdgcn_s_setprio(0); } while (0)
#define PG8_WAIT_V(n) asm volatile("s_waitcnt vmcnt(" #n ")" ::: "memory")
#define PG8_WAIT_L(n) asm volatile("s_waitcnt lgkmcnt(" #n ")" ::: "memory")
#define PG8_BAR __builtin_amdgcn_s_barrier()
#define PG8_SCHED __builtin_amdgcn_sched_barrier(0)
    Unit cur, nxt; int ui = 0;
    if (!S.next(0, cur)) return;
    f32x4 acc[2][2][4][2];
#pragma unroll
    for (int a = 0; a < 2; ++a)
#pragma unroll
        for (int b = 0; b < 2; ++b)
#pragma unroll
            for (int m = 0; m < 4; ++m)
#pragma unroll
                for (int n = 0; n < 2; ++n) acc[a][b][m][n] = (f32x4){0.f, 0.f, 0.f, 0.f};
    bf16x8 At[4][2], B0[2][2], B1[2][2];
    const char* cA = (const char*)g.A + (size_t)cur.pm * tstep; const char* cB = (const char*)g.Bt + (size_t)cur.pn * tstep;
    S.a_ready(cur);
    PG8_STAGE(PG8_SB(0, 0), cB, voffB); PG8_STAGE(PG8_SA(0, 0), cA, voffA); PG8_STAGE(PG8_SB(0, 1), cB + hstep, voffB); PG8_STAGE(PG8_SA(0, 1), cA + hstep, voffA);
    if (wr == 1) PG8_BAR;
    PG8_WAIT_V(4); PG8_BAR;
    PG8_STAGE(PG8_SB(1, 0), cB + kstep, voffB); PG8_STAGE(PG8_SA(1, 0), cA + kstep, voffA); PG8_STAGE(PG8_SB(1, 1), cB + hstep + kstep, voffB);
    PG8_WAIT_V(6); PG8_BAR;
    for (;;) {
        const bool has_next = S.next(ui + 1, nxt);
        const char* nA = has_next ? (const char*)g.A + (size_t)nxt.pm * tstep : cA; const char* nB = has_next ? (const char*)g.Bt + (size_t)nxt.pn * tstep : cB;
        for (int t = 0; t < nt; t += 2) {
            const bool last = (t == nt - 2);
            const char* a1 = cA + (size_t)(t + 1) * kstep;
            const char* a2 = last ? nA : cA + (size_t)(t + 2) * kstep; const char* b2 = last ? nB : cB + (size_t)(t + 2) * kstep;
            const char* a3 = a2 + kstep; const char* b3 = b2 + kstep;
            if (last && has_next) S.a_ready(nxt);
            PG8_LDB(B0, 0, 0); PG8_SCHED; PG8_LDA(At, 0, 0); PG8_STAGE(PG8_SA(1, 1), a1 + hstep, voffA);
            PG8_WAIT_L(8); PG8_BAR; PG8_WAIT_L(0); PG8_MMA(0, 0, At, B0); PG8_BAR; PG8_SCHED;
            PG8_LDB(B1, 0, 1); PG8_STAGE(PG8_SB(0, 0), b2, voffB);
            PG8_BAR; PG8_WAIT_L(0); PG8_MMA(0, 1, At, B1); PG8_BAR;
            PG8_LDA(At, 0, 1); PG8_STAGE(PG8_SA(0, 0), a2, voffA);
            PG8_BAR; PG8_WAIT_L(0); PG8_MMA(1, 0, At, B0); PG8_BAR; PG8_SCHED;
            PG8_STAGE(PG8_SB(0, 1), b2 + hstep, voffB);
            PG8_WAIT_V(6); PG8_BAR; PG8_MMA(1, 1, At, B1); PG8_BAR;
            PG8_LDB(B0, 1, 0); PG8_SCHED; PG8_LDA(At, 1, 0); PG8_STAGE(PG8_SA(0, 1), a2 + hstep, voffA);
            PG8_WAIT_L(8); PG8_BAR; PG8_WAIT_L(0); PG8_MMA(0, 0, At, B0); PG8_BAR; PG8_SCHED;
            PG8_LDB(B1, 1, 1); PG8_STAGE(PG8_SB(1, 0), b3, voffB);
            PG8_BAR; PG8_WAIT_L(0); PG8_MMA(0, 1, At, B1); PG8_BAR;
            PG8_LDA(At, 1, 1); PG8_STAGE(PG8_SA(1, 0), a3, voffA);
            PG8_BAR; PG8_WAIT_L(0); PG8_MMA(1, 0, At, B0); PG8_BAR; PG8_SCHED;
            PG8_STAGE(PG8_SB(1, 1), b3 + hstep, voffB);
            PG8_WAIT_V(6); PG8_BAR; PG8_MMA(1, 1, At, B1); PG8_BAR;
        }
            if constexpr (!Epi::AFTER_DRAIN) { E(acc, cur, wr, wc, fr, fq); S.done(cur); }
            if (!has_next) break;
#pragma unroll
        for (int a = 0; a < 2; ++a)
#pragma unroll
            for (int b = 0; b < 2; ++b)
#pragma unroll
                for (int m = 0; m < 4; ++m)
#pragma unroll
                    for (int n = 0; n < 2; ++n) acc[a][b][m][n] = (f32x4){0.f, 0.f, 0.f, 0.f};
        cur = nxt; cA = nA; cB = nB; ++ui;
    }
    PG8_WAIT_V(0);
    if (wr == 0) PG8_BAR;
    PG8_BAR;
    if constexpr (Epi::AFTER_DRAIN) { E.fused(acc, cur, wr, wc, fr, fq, lds, wid, lane); S.done(cur); }
#undef PG8_SA
#undef PG8_SB
#undef PG8_STAGE
#undef PG8_LDA
#undef PG8_LDB
#undef PG8_MMA
#undef PG8_WAIT_V
#undef PG8_WAIT_L
#undef PG8_BAR
#undef PG8_SCHED
}
}

typedef pg8::bf16_t bf16_t;
typedef pg8::u32x4 u32x4;
DI float bf2f(unsigned short b) { return __uint_as_float(((unsigned)b) << 16); }
DI float bflo(unsigned w) { return __uint_as_float(w << 16); }
DI float bfhi(unsigned w) { return __uint_as_float(w & 0xffff0000u); }

DI void p0_transpose_item(const float* W, int ldw, int K, bf16_t* WT, float* scr, int kb, int nb, int nvalid, int lane) {
    const int k0 = 64 * kb, n0 = 32 * nb, cn = lane & 31;
#pragma unroll 8
    for (int i = 0; i < 32; ++i) { const int kk = 2 * i + (lane >> 5); scr[kk * 33 + cn] = cn < nvalid ? W[(size_t)(k0 + kk) * ldw + n0 + cn] : 0.f; }
    asm volatile("s_waitcnt lgkmcnt(0)" ::: "memory");
    const int c = lane & 7;
#pragma unroll
    for (int j = 0; j < 4; ++j) {
        const int n = (lane >> 3) + 8 * j; const float* sp = scr + (8 * c) * 33 + n;
        u32x4 o; o.x = pg8::cvt_pk_bf16(sp[0 * 33], sp[1 * 33]); o.y = pg8::cvt_pk_bf16(sp[2 * 33], sp[3 * 33]);
        o.z = pg8::cvt_pk_bf16(sp[4 * 33], sp[5 * 33]); o.w = pg8::cvt_pk_bf16(sp[6 * 33], sp[7 * 33]);
        *(u32x4*)(WT + (size_t)(n0 + n) * K + k0 + 8 * c) = o;
    }
    asm volatile("s_waitcnt lgkmcnt(0)" ::: "memory");
}
DI void phase_weights(const Params& p, float* lds) {
    const int lane = threadIdx.x & 63, wave = threadIdx.x >> 6;
    float* scr = lds + wave * (64 * 33);
    bf16_t* WinT = (bf16_t*)(p.ws + WS_WINT); bf16_t* WoutT = (bf16_t*)(p.ws + WS_WOUTT); bf16_t* WgluT = (bf16_t*)(p.ws + WS_WGLUT);
    constexpr int I_IN = 16 * 97, I_OUT = 16 * 32, I_GLU = 8 * 16;
    for (int it = blockIdx.x * 8 + wave; it < I_IN + I_OUT + I_GLU; it += gridDim.x * 8) {
        int r = it;
        if (r < I_IN) { const int kb = r / 97, nb = r % 97; p0_transpose_item(p.w_in, PIN, DM, WinT, scr, kb, nb, nb == 96 ? 16 : 32, lane); continue; }
        r -= I_IN;
        if (r < I_OUT) { p0_transpose_item(p.w_out, 1024, 1024, WoutT, scr, r / 32, r % 32, 32, lane); continue; }
        r -= I_OUT;
        p0_transpose_item(p.w_glu, 512, 512, WgluT, scr, r / 16, r % 16, 32, lane);
    }
    u32x4* z = (u32x4*)(WinT + (size_t)3104 * DM);
    for (int i = blockIdx.x * NTHR + threadIdx.x; i < 224 * DM / 8; i += gridDim.x * NTHR) z[i] = (u32x4){0u, 0u, 0u, 0u};
}
DI void phase_modulate(const Params& p) {
    const int lane = threadIdx.x & 63, wave = threadIdx.x >> 6;
    const float* ADA = (const float*)(p.ws + WS_ADA); bf16_t* HB = (bf16_t*)(p.ws + WS_HB);
    for (int r = blockIdx.x * 8 + wave; r < NT; r += gridDim.x * 8) {
        const int b = r / TPB, t = r % TPB;
        const float* src = t < CTXL ? p.ctx + ((size_t)b * CTXL + t) * DM : p.x + ((size_t)b * SEQ + (t - CTXL)) * DM;
        const float* ad = ADA + (t < CTXL ? 16 : b) * 3072;
#pragma unroll
        for (int j = 0; j < 2; ++j) {
            const int k = j * 512 + lane * 8;
            const f32x4 v0 = *(const f32x4*)(src + k), v1 = *(const f32x4*)(src + k + 4);
            const f32x4 s0 = *(const f32x4*)(ad + 1024 + k), s1 = *(const f32x4*)(ad + 1024 + k + 4), h0 = *(const f32x4*)(ad + k), h1 = *(const f32x4*)(ad + k + 4);
            const f32x4 a = v0 * (s0 + 1.0f) + h0, c = v1 * (s1 + 1.0f) + h1;
            u32x4 o; o.x = pg8::cvt_pk_bf16(a[0], a[1]); o.y = pg8::cvt_pk_bf16(a[2], a[3]); o.z = pg8::cvt_pk_bf16(c[0], c[1]); o.w = pg8::cvt_pk_bf16(c[2], c[3]);
            *(u32x4*)(HB + (size_t)r * DM + k) = o;
        }
    }
}
struct EpiInprojMK {
    static constexpr bool PERM = true, AFTER_DRAIN = false;
    bf16_t *UG, *ZS, *QKV, *ZG; float* GL;
    DI void operator()(const f32x4 (&acc)[2][2][4][2], const pg8::Unit& u, int wr, int wc, int fr, int fq) const {
        const int b = u.pm / 9, t0 = (u.pm % 9) * 256, pn = u.pn;
        const int cl0 = wc * 32 + 8 * fq;
        if (pn == 12) {
            if (cl0 < 16) {
#pragma unroll
                for (int ai = 0; ai < 2; ++ai)
#pragma unroll
                    for (int m = 0; m < 4; ++m) {
                        const size_t row = (size_t)u.pm * 256 + ai * 128 + wr * 64 + m * 16 + fr;
                        *(f32x4*)(GL + row * 16 + cl0) = acc[ai][0][m][0]; *(f32x4*)(GL + row * 16 + cl0 + 4) = acc[ai][0][m][1];
                    }
            }
            return;
        }
        bf16_t* base[2]; int rs, rowadd;
#pragma unroll
        for (int bj = 0; bj < 2; ++bj) {
            const int cl = cl0 + bj * 128;
            if (pn < 2) { const int col = pn * 256 + cl; base[bj] = UG + ((size_t)(b * 32 + (col >> 4)) * TPB) * 16 + (col & 15); }
            else if (pn < 4) base[bj] = ZS + (pn - 2) * 256 + cl;
            else if (pn < 10) base[bj] = QKV + (pn - 4) * 256 + cl;
            else base[bj] = ZG + (pn - 10) * 256 + cl;
        }
        if (pn < 2) { rs = 16; rowadd = t0; } else if (pn >= 4 && pn < 10) { rs = 1536; rowadd = u.pm * 256; } else { rs = 512; rowadd = u.pm * 256; }
#pragma unroll
        for (int ai = 0; ai < 2; ++ai)
#pragma unroll
            for (int m = 0; m < 4; ++m) {
                const size_t ro = (size_t)(rowadd + ai * 128 + wr * 64 + m * 16 + fr) * rs;
#pragma unroll
                for (int bj = 0; bj < 2; ++bj) {
                    const f32x4 v0 = acc[ai][bj][m][0], v1 = acc[ai][bj][m][1];
                    u32x4 w; w.x = pg8::cvt_pk_bf16(v0[0], v0[1]); w.y = pg8::cvt_pk_bf16(v0[2], v0[3]); w.z = pg8::cvt_pk_bf16(v1[0], v1[1]); w.w = pg8::cvt_pk_bf16(v1[2], v1[3]);
                    *(u32x4*)(base[bj] + ro) = w;
                }
            }
    }
};
struct EpiGluMK {
    static constexpr bool PERM = true, AFTER_DRAIN = false;
    const bf16_t *G, *ZS; const float* b_glu; bf16_t* MIX;
    DI void operator()(const f32x4 (&acc)[2][2][4][2], const pg8::Unit& u, int wr, int wc, int fr, int fq) const {
        const int b = u.pm / 8;
#pragma unroll
        for (int bj = 0; bj < 2; ++bj) {
            const int col = u.pn * 256 + bj * 128 + wc * 32 + 8 * fq;
            const f32x4 b0 = *(const f32x4*)(b_glu + col), b1 = *(const f32x4*)(b_glu + col + 4);
#pragma unroll
            for (int ai = 0; ai < 2; ++ai)
#pragma unroll
                for (int m = 0; m < 4; ++m) {
                    const int r = u.pm * 256 + ai * 128 + wr * 64 + m * 16 + fr;
                    const size_t rnt = (size_t)b * TPB + CTXL + (r - b * SEQ);
                    const u32x4 g = *(const u32x4*)(G + (size_t)r * 512 + col), z = *(const u32x4*)(ZS + rnt * 512 + col);
                    const f32x4 s0 = acc[ai][bj][m][0] + b0, s1 = acc[ai][bj][m][1] + b1;
                    float o[8];
                    o[0] = bflo(g.x) * sigmoid_f(s0[0]) * silu_f(bflo(z.x)); o[1] = bfhi(g.x) * sigmoid_f(s0[1]) * silu_f(bfhi(z.x));
                    o[2] = bflo(g.y) * sigmoid_f(s0[2]) * silu_f(bflo(z.y)); o[3] = bfhi(g.y) * sigmoid_f(s0[3]) * silu_f(bfhi(z.y));
                    o[4] = bflo(g.z) * sigmoid_f(s1[0]) * silu_f(bflo(z.z)); o[5] = bfhi(g.z) * sigmoid_f(s1[1]) * silu_f(bfhi(z.z));
                    o[6] = bflo(g.w) * sigmoid_f(s1[2]) * silu_f(bflo(z.w)); o[7] = bfhi(g.w) * sigmoid_f(s1[3]) * silu_f(bfhi(z.w));
                    u32x4 w; w.x = pg8::cvt_pk_bf16(o[0], o[1]); w.y = pg8::cvt_pk_bf16(o[2], o[3]); w.z = pg8::cvt_pk_bf16(o[4], o[5]); w.w = pg8::cvt_pk_bf16(o[6], o[7]);
                    *(u32x4*)(MIX + (size_t)r * 1024 + col) = w;
                }
        }
    }
};


typedef float f32x16 __attribute__((ext_vector_type(16)));
typedef unsigned u32x2 __attribute__((ext_vector_type(2)));
typedef pg8::bf16x8 bf16x8;
#define MFMA32(a, b, c) __builtin_amdgcn_mfma_f32_32x32x16_bf16((a), (b), (c), 0, 0, 0)

DI void s5_build_tables(const Params& p, float* lds, int g) {
    float* AP = lds;
    float* BB = lds + 4352;
    float* CC = lds + 8448;
    float* KK = lds + 12544;
    const int tid = threadIdx.x;
    if (tid < 128) {
        const int d = tid >> 6, pi = tid & 63, dg = d * 32 + g;
        const double lre = p.lre[dg * 64 + pi], lim = p.lim[dg * 64 + pi], dt = (double)expf(p.logdt[dg]);
        for (int tau = 0; tau <= 16; ++tau) {
            double ang = lim * dt * (double)tau; ang -= 6.283185307179586477 * rint(ang * 0.15915494309189533577);
            float sn, cs; sincosf((float)ang, &sn, &cs);
            const float mag = expf((float)(lre * dt * (double)tau));
            AP[((d * 64 + pi) * 17 + tau) * 2] = mag * cs; AP[((d * 64 + pi) * 17 + tau) * 2 + 1] = mag * sn;
        }
        const double ar_d = AP[((d * 64 + pi) * 17 + 1) * 2], ai_d = AP[((d * 64 + pi) * 17 + 1) * 2 + 1];
        const double nr = ar_d - 1.0, ni = ai_d, den = lre * lre + lim * lim;
        const float cfr = (float)((nr * lre + ni * lim) / den), cfi = (float)((ni * lre - nr * lim) / den);
        for (int c = 0; c < 16; ++c) {
            const float br = p.bre[((size_t)dg * 64 + pi) * 16 + c], bi = p.bim[((size_t)dg * 64 + pi) * 16 + c];
            BB[((d * 64 + pi) * 16 + c) * 2] = cfr * br - cfi * bi; BB[((d * 64 + pi) * 16 + c) * 2 + 1] = cfr * bi + cfi * br;
        }
        float* A16 = (float*)(p.ws + WS_A16) + ((g * 2 + d) * 64 + pi) * 2;
        A16[0] = AP[((d * 64 + pi) * 17 + 16) * 2]; A16[1] = AP[((d * 64 + pi) * 17 + 16) * 2 + 1];
    }
    for (int i = tid; i < 2 * 16 * 64; i += NTHR) {
        const int d = i >> 10, c = (i >> 6) & 15, pi = i & 63, dg = d * 32 + g;
        CC[i * 2] = p.cre[((size_t)dg * 16 + c) * 64 + pi]; CC[i * 2 + 1] = p.cim[((size_t)dg * 16 + c) * 64 + pi];
    }
    __syncthreads();
    for (int i = 0; i < 16; ++i) {
        const int idx = tid + NTHR * i, d = idx >> 12, tau = (idx >> 8) & 15, c = (idx >> 4) & 15, c2 = idx & 15;
        float sum = 0.f;
        for (int pi = 0; pi < 64; ++pi) {
            const float cr = CC[((d * 16 + c) * 64 + pi) * 2], ci = CC[((d * 16 + c) * 64 + pi) * 2 + 1];
            const float ar = AP[((d * 64 + pi) * 17 + tau) * 2], ai = AP[((d * 64 + pi) * 17 + tau) * 2 + 1];
            const float br = BB[((d * 64 + pi) * 16 + c2) * 2], bi = BB[((d * 64 + pi) * 16 + c2) * 2 + 1];
            const float xr = cr * ar - ci * ai, xi = cr * ai + ci * ar;
            sum += xr * br - xi * bi;
        }
        KK[idx] = sum;
    }
    __syncthreads();
    bf16_t* T1F = (bf16_t*)(p.ws + WS_TAB + (size_t)g * TAB_G_BYTES); bf16_t* T2F = T1F + 131072;
    for (int q = tid; q < 16384 + 8192; q += NTHR) {
        float v[8];
        if (q < 16384) {
            const int mt = q >> 10, ks = (q >> 6) & 15, ln = q & 63, row = mt * 32 + (ln & 31), hh = ln >> 5, sl = ks;
#pragma unroll
            for (int j = 0; j < 8; ++j) {
                const int c2 = 8 * hh + j;
                if (row < 256) {
                    const int tl = row >> 4, c = row & 15;
                    float val = 0.f;
                    if (sl <= tl) val += KK[((0 * 16 + (tl - sl)) * 16 + c) * 16 + c2];
                    if (sl >= tl) val += KK[((1 * 16 + (sl - tl)) * 16 + c) * 16 + c2];
                    if (sl == tl && c == c2) val += p.s5d[g * 16 + c];
                    v[j] = val;
                } else {
                    const int st = row - 256, d = st >> 7, ri = (st >> 6) & 1, pi = st & 63, tau = d ? sl : 15 - sl;
                    const float ar = AP[((d * 64 + pi) * 17 + tau) * 2], ai = AP[((d * 64 + pi) * 17 + tau) * 2 + 1];
                    const float br = BB[((d * 64 + pi) * 16 + c2) * 2], bi = BB[((d * 64 + pi) * 16 + c2) * 2 + 1];
                    v[j] = ri ? (ar * bi + ai * br) : (ar * br - ai * bi);
                }
            }
            u32x4 o; o.x = pg8::cvt_pk_bf16(v[0], v[1]); o.y = pg8::cvt_pk_bf16(v[2], v[3]); o.z = pg8::cvt_pk_bf16(v[4], v[5]); o.w = pg8::cvt_pk_bf16(v[6], v[7]);
            *(u32x4*)(T1F + (size_t)q * 8) = o;
        } else {
            const int q2 = q - 16384, mt = q2 >> 10, ks = (q2 >> 6) & 15, ln = q2 & 63, row = mt * 32 + (ln & 31), hh = ln >> 5, tl = row >> 4, c = row & 15;
#pragma unroll
            for (int j = 0; j < 8; ++j) {
                const int st = ks * 16 + 8 * hh + j, d = st >> 7, ri = (st >> 6) & 1, pi = st & 63, tau = d ? 16 - tl : tl + 1;
                const float cr = CC[((d * 16 + c) * 64 + pi) * 2], ci = CC[((d * 16 + c) * 64 + pi) * 2 + 1];
                const float ar = AP[((d * 64 + pi) * 17 + tau) * 2], ai = AP[((d * 64 + pi) * 17 + tau) * 2 + 1];
                v[j] = ri ? -(cr * ai + ci * ar) : (cr * ar - ci * ai);
            }
            u32x4 o; o.x = pg8::cvt_pk_bf16(v[0], v[1]); o.y = pg8::cvt_pk_bf16(v[2], v[3]); o.z = pg8::cvt_pk_bf16(v[4], v[5]); o.w = pg8::cvt_pk_bf16(v[6], v[7]);
            *(u32x4*)(T2F + (size_t)q2 * 8) = o;
        }
    }
}

DI void s5_unit(const Params& p, unsigned char* smem, int u) {
    const int tid = threadIdx.x, lane = tid & 63, wave = __builtin_amdgcn_readfirstlane(tid >> 6), b = u >> 5, g = u & 31;
    const int n31 = lane & 31, hh = lane >> 5;
    unsigned char* UT = smem;
    float* SH = (float*)smem;
    {
        const u32x4* src = (const u32x4*)((const bf16_t*)(p.ws + WS_UG) + (size_t)(b * 32 + g) * TPB * 16);
#pragma unroll
        for (int i = 0; i < 9; ++i) { const int q = tid + NTHR * i; *(u32x4*)(UT + (q >> 5) * 528 + (q & 31) * 16) = src[q]; }
    }
    __syncthreads();
    const u32x4* T1F = (const u32x4*)(p.ws + WS_TAB + (size_t)g * TAB_G_BYTES);
    const u32x4* T2F = T1F + 16384;
    f32x16 accY[4], accS[5];
#pragma unroll
    for (int j = 0; j < 4; ++j)
#pragma unroll
        for (int r = 0; r < 16; ++r) accY[j][r] = 0.f;
#pragma unroll
    for (int j = 0; j < 5; ++j)
#pragma unroll
        for (int r = 0; r < 16; ++r) accS[j][r] = 0.f;
    {
        const u32x4* aP = T1F + (size_t)(wave * 16) * 64 + lane;
#pragma unroll 4
        for (int ks = 0; ks < 16; ++ks) {
            const bf16x8 a = __builtin_bit_cast(bf16x8, aP[ks * 64]);
#pragma unroll
            for (int j = 0; j < 4; ++j) {
                const bf16x8 bv = *(const bf16x8*)(UT + (16 + 32 * j + n31) * 528 + ks * 32 + hh * 16);
                accY[j] = MFMA32(a, bv, accY[j]);
            }
        }
    }
    {
        const u32x4* aP = T1F + (size_t)((8 + wave) * 16) * 64 + lane;
#pragma unroll 4
        for (int ks = 0; ks < 16; ++ks) {
            const bf16x8 a = __builtin_bit_cast(bf16x8, aP[ks * 64]);
#pragma unroll
            for (int j = 0; j < 5; ++j) {
                const bf16x8 bv = *(const bf16x8*)(UT + (32 * j + n31) * 528 + ks * 32 + hh * 16);
                accS[j] = MFMA32(a, bv, accS[j]);
            }
        }
    }
    __syncthreads();
#pragma unroll
    for (int j = 0; j < 5; ++j) {
        const int n = 32 * j + n31;
        if (n < 144) {
#pragma unroll
            for (int q = 0; q < 4; ++q)
                *(f32x4*)(SH + n * 260 + wave * 32 + 8 * q + 4 * hh) = (f32x4){accS[j][4 * q], accS[j][4 * q + 1], accS[j][4 * q + 2], accS[j][4 * q + 3]};
        }
    }
    __syncthreads();
    if (tid < 128) {
        const int d = tid >> 6, pi = tid & 63;
        const float* A16 = (const float*)(p.ws + WS_A16) + ((g * 2 + d) * 64 + pi) * 2;
        const float ar = A16[0], ai = A16[1];
        float hr = 0.f, hi = 0.f;
        float* col = SH + d * 128 + pi;
        for (int s0 = 0; s0 < 144; s0 += 8) {
            float sr[8], si[8];
#pragma unroll
            for (int k = 0; k < 8; ++k) { const int st = s0 + k, n = d == 0 ? st : (st < 16 ? 15 - st : 159 - st); sr[k] = col[n * 260]; si[k] = col[n * 260 + 64]; }
#pragma unroll
            for (int k = 0; k < 8; ++k) {
                const int st = s0 + k, n = d == 0 ? st : (st < 16 ? 15 - st : 159 - st);
                col[n * 260] = hr; col[n * 260 + 64] = hi;
                const float nr = ar * hr - ai * hi + sr[k], ni = ar * hi + ai * hr + si[k];
                hr = nr; hi = ni;
            }
        }
    }
    __syncthreads();
    {
        const u32x4* aP = T2F + (size_t)(wave * 16) * 64 + lane;
#pragma unroll 4
        for (int ks = 0; ks < 16; ++ks) {
            const bf16x8 a = __builtin_bit_cast(bf16x8, aP[ks * 64]);
#pragma unroll
            for (int j = 0; j < 4; ++j) {
                const float* hp = SH + (16 + 32 * j + n31) * 260 + ks * 16 + 8 * hh;
                const f32x4 x0 = *(const f32x4*)hp, x1 = *(const f32x4*)(hp + 4);
                u32x4 w; w.x = pg8::cvt_pk_bf16(x0[0], x0[1]); w.y = pg8::cvt_pk_bf16(x0[2], x0[3]); w.z = pg8::cvt_pk_bf16(x1[0], x1[1]); w.w = pg8::cvt_pk_bf16(x1[2], x1[3]);
                accY[j] = MFMA32(a, __builtin_bit_cast(bf16x8, w), accY[j]);
            }
        }
    }
    {
        bf16_t* G = (bf16_t*)(p.ws + WS_G);
#pragma unroll
        for (int j = 0; j < 4; ++j) {
            const int tokbase = 16 * (32 * j + n31);
#pragma unroll
            for (int q = 0; q < 4; ++q) {
                const int cr0 = 8 * q + 4 * hh, tl = 2 * wave + (cr0 >> 4), c0 = cr0 & 15;
                u32x2 w; w.x = pg8::cvt_pk_bf16(gelu_f(accY[j][4 * q]), gelu_f(accY[j][4 * q + 1])); w.y = pg8::cvt_pk_bf16(gelu_f(accY[j][4 * q + 2]), gelu_f(accY[j][4 * q + 3]));
                *(u32x2*)(G + ((size_t)b * SEQ + tokbase + tl) * 512 + g * 16 + c0) = w;
            }
        }
    }
    __syncthreads();
}


#define MFMA16(a, b, c) __builtin_amdgcn_mfma_f32_16x16x32_bf16((a), (b), (c), 0, 0, 0)
DI bf16x8 mk8(unsigned a, unsigned b, unsigned c, unsigned d) { u32x4 w; w.x = a; w.y = b; w.z = c; w.w = d; return __builtin_bit_cast(bf16x8, w); }
DI bf16x8 packlo(const f32x4 a) { return mk8(pg8::cvt_pk_bf16(a[0], a[1]), pg8::cvt_pk_bf16(a[2], a[3]), 0u, 0u); }
DI bf16x8 pack2(const f32x4 a, const f32x4 b) { return mk8(pg8::cvt_pk_bf16(a[0], a[1]), pg8::cvt_pk_bf16(a[2], a[3]), pg8::cvt_pk_bf16(b[0], b[1]), pg8::cvt_pk_bf16(b[2], b[3])); }
DI bf16x8 ld_pair(const unsigned char* rowp, int off_lo, int off_hi) { const u32x2 lo = *(const u32x2*)(rowp + off_lo), hi = *(const u32x2*)(rowp + off_hi); return mk8(lo.x, lo.y, hi.x, hi.y); }
DI bf16x8 ld_single(const unsigned char* rowp, int off) { const u32x2 lo = *(const u32x2*)(rowp + off); return mk8(lo.x, lo.y, 0u, 0u); }
DI void st_bf16(unsigned char* p, float v) { *(unsigned short*)p = (unsigned short)(pg8::cvt_pk_bf16(v, 0.f) & 0xffffu); }

constexpr int LQ_OFF = 0, LK_OFF = 17408, LV_OFF = 34816;
constexpr int LGT_OFF = 52224;
constexpr int LAF_OFF = 55808;
constexpr int LNA_OFF = 64000, LPP_OFF = 80384, LXI_OFF = 96768;
constexpr int GQ_OFF = 0, GKT_OFF = 17408, GVT_OFF = 35840, GW_OFF = 54272, GP_OFF = 71680, GNA_OFF = 80896, GXI_OFF = 90112, GGT_OFF = 93184;

DI void phase_gdn_local(const Params& p, unsigned char* smem) {
    const int tid = threadIdx.x, lane = tid & 63, wave = __builtin_amdgcn_readfirstlane(tid >> 6);
    const int r16 = lane & 15, kq = lane >> 4;
    bf16_t* KTg = (bf16_t*)(p.ws + WS_KT); bf16_t* VTg = (bf16_t*)(p.ws + WS_VT);
    float* GT = (float*)(smem + LGT_OFF); float* AF = (float*)(smem + LAF_OFF);
    for (int unit = blockIdx.x; unit < NB * 36 * 4; unit += gridDim.x) {
        const int b = unit / 144, c = (unit >> 2) % 36, h = unit & 3;
        const size_t rowbase = (size_t)b * TPB + 64 * c;
        {
            {
#pragma unroll
                for (int i = 0; i < 6; ++i) {
                    const int q = tid + NTHR * i, mat = q >> 10, qq = q & 1023, row = qq >> 4, c16 = qq & 15;
                    const size_t wsoff = mat == 0 ? WS_QC : (mat == 1 ? WS_KC : WS_VC);
                    const u32x4 v = *(const u32x4*)((const bf16_t*)(p.ws + wsoff) + (rowbase + row) * 512 + h * 128 + c16 * 8);
                    *(u32x4*)(smem + (mat == 0 ? LQ_OFF : (mat == 1 ? LK_OFF : LV_OFF)) + row * 272 + c16 * 16) = v;
                }
                if (tid < 128) {
                    const int d = tid >> 6, tok = tid & 63, j = d * 4 + h;
                    const size_t r = rowbase + tok;
                    GT[(d * 6 + 0) * 64 + tok] = ((const float*)(p.ws + WS_GDEC))[r * 8 + j];
                    GT[(d * 6 + 4) * 64 + tok] = ((const float*)(p.ws + WS_BETA))[r * 8 + j];
                }
            }
            __syncthreads();
            if (wave < 2) {
                const int d = wave;
                float x = GT[(d * 6 + 0) * 64 + lane];
#pragma unroll
                for (int o = 1; o < 64; o <<= 1) {
                    const float y = d == 0 ? __shfl_up(x, o) : __shfl_down(x, o);
                    const bool ok = d == 0 ? (lane >= o) : (lane + o < 64);
                    if (ok) x += y;
                }
                const float tot = __shfl(x, d == 0 ? 63 : 0);
                const float gam = __expf(x), be = GT[(d * 6 + 4) * 64 + lane];
                GT[(d * 6 + 1) * 64 + lane] = x; GT[(d * 6 + 2) * 64 + lane] = gam; GT[(d * 6 + 3) * 64 + lane] = __expf(tot - x);
                GT[(d * 6 + 5) * 64 + lane] = be * gam;
                if (lane == 0) GT[12 * 64 + d] = __expf(tot);
            }
            __syncthreads();
            {
                const int mi = wave >> 1;
                f32x4 aK[2] = {{0.f, 0.f, 0.f, 0.f}, {0.f, 0.f, 0.f, 0.f}}, aQ[2] = {{0.f, 0.f, 0.f, 0.f}, {0.f, 0.f, 0.f, 0.f}};
#pragma unroll
                for (int ks = 0; ks < 4; ++ks) {
                    const bf16x8 fk = *(const bf16x8*)(smem + LK_OFF + (16 * mi + r16) * 272 + (32 * ks + 8 * kq) * 2);
                    const bf16x8 fq = *(const bf16x8*)(smem + LQ_OFF + (16 * mi + r16) * 272 + (32 * ks + 8 * kq) * 2);
#pragma unroll
                    for (int tt = 0; tt < 2; ++tt) {
                        const int nj = 2 * (wave & 1) + tt;
                        const bf16x8 fb = *(const bf16x8*)(smem + LK_OFF + (16 * nj + r16) * 272 + (32 * ks + 8 * kq) * 2);
                        aK[tt] = MFMA16(fk, fb, aK[tt]); aQ[tt] = MFMA16(fq, fb, aQ[tt]);
                    }
                }
#pragma unroll
                for (int tt = 0; tt < 2; ++tt) {
                    const int nj = 2 * (wave & 1) + tt, j = 16 * nj + r16;
#pragma unroll
                    for (int d = 0; d < 2; ++d) {
                        const float gcj = GT[(d * 6 + 1) * 64 + j];
#pragma unroll
                        for (int r = 0; r < 4; ++r) {
                            const int i = 16 * mi + 4 * kq + r;
                            const bool strict = d ? (j > i) : (j < i), incl = strict || (i == j);
                            const float e = incl ? __expf(GT[(d * 6 + 1) * 64 + i] - gcj) : 0.f;
                            const float a = strict ? GT[(d * 6 + 4) * 64 + i] * aK[tt][r] * e : 0.f;
                            st_bf16(smem + LNA_OFF + ((d * 64 + i) * 64 + j) * 2, -a);
                            st_bf16(smem + LPP_OFF + ((d * 64 + i) * 64 + j) * 2, aQ[tt][r] * e);
                            if (mi == nj) AF[((d * 4 + mi) * 16 + 4 * kq + r) * 16 + r16] = a;
                        }
                    }
                }
            }
            __syncthreads();
            if (lane < 16) {
                const int d = wave >> 2, I = wave & 3, cc = lane;
                const float* ab = AF + (d * 4 + I) * 256;
                float x[16];
                if (d == 0) {
#pragma unroll
                    for (int i = 0; i < 16; ++i) { float sacc = (i == cc) ? 1.f : 0.f;
#pragma unroll
                        for (int j = 0; j < 16; ++j) if (j < i) sacc -= ab[i * 16 + j] * x[j];
                        x[i] = sacc; }
                } else {
#pragma unroll
                    for (int ii = 0; ii < 16; ++ii) { const int i = 15 - ii; float sacc = (i == cc) ? 1.f : 0.f;
#pragma unroll
                        for (int j = 0; j < 16; ++j) if (j > i) sacc -= ab[i * 16 + j] * x[j];
                        x[i] = sacc; }
                }
#pragma unroll
                for (int i = 0; i < 16; ++i) st_bf16(smem + LXI_OFF + ((d * 64 + 16 * I + i) * 16 + cc) * 2, x[i]);
            }
            __syncthreads();
            {
                const size_t tile = ((size_t)(b * 4 + h) * 36 + c) * 8192;
                for (int q = tid; q < 2048; q += NTHR) {
                    const int mat = q >> 10, qq = q & 1023, dd = qq >> 3, t8 = qq & 7;
                    const unsigned char* src = smem + (mat ? LV_OFF : LK_OFF) + dd * 2;
                    unsigned short e[8];
#pragma unroll
                    for (int jj = 0; jj < 8; ++jj) e[jj] = *(const unsigned short*)(src + (8 * t8 + jj) * 272);
                    u32x4 o; o.x = e[0] | ((unsigned)e[1] << 16); o.y = e[2] | ((unsigned)e[3] << 16); o.z = e[4] | ((unsigned)e[5] << 16); o.w = e[6] | ((unsigned)e[7] << 16);
                    *(u32x4*)((mat ? VTg : KTg) + tile + (size_t)qq * 8) = o;
                }
                for (int q = tid; q < 2 * 1232; q += NTHR) {
                    const int d = q / 1232, qq = q % 1232;
                    unsigned char* dst = p.ws + WS_LOC + ((size_t)((b * 4 + h) * 2 + d) * 36 + c) * LOC_BYTES;
                    u32x4 v;
                    if (qq < 512) v = *(const u32x4*)(smem + LNA_OFF + d * 8192 + qq * 16);
                    else if (qq < 1024) v = *(const u32x4*)(smem + LPP_OFF + d * 8192 + (qq - 512) * 16);
                    else if (qq < 1152) v = *(const u32x4*)(smem + LXI_OFF + d * 2048 + (qq - 1024) * 16);
                    else { const int gq = qq - 1152; v = *(const u32x4*)(smem + LGT_OFF + ((d * 6 + 2) * 64) * 4 + gq * 16); if (gq >= 64) v = (u32x4){__float_as_uint(GT[12 * 64 + d]), 0u, 0u, 0u}; }
                    *(u32x4*)(dst + qq * 16) = v;
                }
            }
            __syncthreads();
        }
    }
}

DI void gdn_tri_solve(f32x4 (&R)[4], const unsigned char* NA, const unsigned char* XI, int dir, int r16, int kq) {
    const f32x4 z4 = (f32x4){0.f, 0.f, 0.f, 0.f};
#define NA_ROW(I) (NA + (16 * (I) + r16) * 144)
#define XI_F(I) ld_single(XI + (16 * (I) + r16) * 48, kq * 8)
    if (dir == 0) {
        R[0] = MFMA16(XI_F(0), packlo(R[0]), z4);
        R[1] = MFMA16(ld_single(NA_ROW(1), (0 + 4 * kq) * 2), packlo(R[0]), R[1]);
        R[1] = MFMA16(XI_F(1), packlo(R[1]), z4);
        R[2] = MFMA16(ld_pair(NA_ROW(2), (0 + 4 * kq) * 2, (16 + 4 * kq) * 2), pack2(R[0], R[1]), R[2]);
        R[2] = MFMA16(XI_F(2), packlo(R[2]), z4);
        R[3] = MFMA16(ld_pair(NA_ROW(3), (0 + 4 * kq) * 2, (16 + 4 * kq) * 2), pack2(R[0], R[1]), R[3]);
        R[3] = MFMA16(ld_single(NA_ROW(3), (32 + 4 * kq) * 2), packlo(R[2]), R[3]);
        R[3] = MFMA16(XI_F(3), packlo(R[3]), z4);
    } else {
        R[3] = MFMA16(XI_F(3), packlo(R[3]), z4);
        R[2] = MFMA16(ld_single(NA_ROW(2), (48 + 4 * kq) * 2), packlo(R[3]), R[2]);
        R[2] = MFMA16(XI_F(2), packlo(R[2]), z4);
        R[1] = MFMA16(ld_pair(NA_ROW(1), (32 + 4 * kq) * 2, (48 + 4 * kq) * 2), pack2(R[2], R[3]), R[1]);
        R[1] = MFMA16(XI_F(1), packlo(R[1]), z4);
        R[0] = MFMA16(ld_pair(NA_ROW(0), (32 + 4 * kq) * 2, (48 + 4 * kq) * 2), pack2(R[2], R[3]), R[0]);
        R[0] = MFMA16(ld_single(NA_ROW(0), (16 + 4 * kq) * 2), packlo(R[1]), R[0]);
        R[0] = MFMA16(XI_F(0), packlo(R[0]), z4);
    }
#undef NA_ROW
#undef XI_F
}

DI void gdn_unit(const Params& p, unsigned char* smem, int u) {
    const int tid = threadIdx.x, lane = tid & 63, wave = __builtin_amdgcn_readfirstlane(tid >> 6);
    const int b = u >> 3, h = (u >> 1) & 3, dir = u & 1;
    const int r16 = lane & 15, kq = lane >> 4;
    const unsigned char* QCb = (const unsigned char*)(p.ws + WS_QC) + ((size_t)b * TPB * 512 + h * 128) * 2;
    const unsigned char* KTb = (const unsigned char*)(p.ws + WS_KT) + (size_t)(b * 4 + h) * 36 * 16384;
    const unsigned char* VTb = (const unsigned char*)(p.ws + WS_VT) + (size_t)(b * 4 + h) * 36 * 16384;
    const unsigned char* LOCb = (const unsigned char*)(p.ws + WS_LOC) + (size_t)((b * 4 + h) * 2 + dir) * 36 * LOC_BYTES;
    float* OG = p.out + (size_t)dir * NL * 512;
    const float* GGT = (const float*)(smem + GGT_OFF);
    f32x4 Sacc[8]; bf16x8 Sb[4];
#pragma unroll
    for (int m = 0; m < 8; ++m) Sacc[m] = (f32x4){0.f, 0.f, 0.f, 0.f};
#pragma unroll
    for (int ks = 0; ks < 4; ++ks) Sb[ks] = mk8(0u, 0u, 0u, 0u);
    u32x4 pf[9];
#define GDN_CHUNK(st) (dir == 0 ? (st) : ((st) < 4 ? 3 - (st) : 39 - (st)))
#define GDN_PREFETCH(cc) do { _Pragma("unroll") for (int i_ = 0; i_ < 9; ++i_) { const int q_ = tid + NTHR * i_; \
        const unsigned char* s_; \
        if (i_ < 2) s_ = QCb + (size_t)(64 * (cc) + (q_ >> 4)) * 1024 + (q_ & 15) * 16; \
        else if (i_ < 4) s_ = KTb + (size_t)(cc) * 16384 + (q_ - 1024) * 16; \
        else if (i_ < 6) s_ = VTb + (size_t)(cc) * 16384 + (q_ - 2048) * 16; \
        else s_ = LOCb + (size_t)(cc) * LOC_BYTES + (q_ - 3072) * 16; \
        if (q_ < 4304) pf[i_] = *(const u32x4*)s_; } } while (0)
    GDN_PREFETCH(GDN_CHUNK(0));
    for (int st = 0; st < 36; ++st) {
        const int c = GDN_CHUNK(st);
        __syncthreads();
#pragma unroll
        for (int i = 0; i < 9; ++i) {
            const int q = tid + NTHR * i; unsigned char* dptr;
            if (i < 2) dptr = smem + GQ_OFF + (q >> 4) * 272 + (q & 15) * 16;
            else if (i < 4) dptr = smem + GKT_OFF + ((q - 1024) >> 3) * 144 + ((q - 1024) & 7) * 16;
            else if (i < 6) dptr = smem + GVT_OFF + ((q - 2048) >> 3) * 144 + ((q - 2048) & 7) * 16;
            else if (i < 7) dptr = smem + GNA_OFF + ((q - 3072) >> 3) * 144 + ((q - 3072) & 7) * 16;
            else if (i < 8) dptr = smem + GP_OFF + ((q - 3584) >> 3) * 144 + ((q - 3584) & 7) * 16;
            else if (q < 4224) dptr = smem + GXI_OFF + ((q - 4096) >> 1) * 48 + ((q - 4096) & 1) * 16;
            else dptr = smem + GGT_OFF + (q - 4224) * 16;
            if (q < 4304) *(u32x4*)dptr = pf[i];
        }
        if (st + 1 < 36) { const int cn = GDN_CHUNK(st + 1); GDN_PREFETCH(cn); }
        __syncthreads();
        {
            f32x4 R[4];
#pragma unroll
            for (int mi = 0; mi < 4; ++mi) {
                const u32x2 kv = *(const u32x2*)(smem + GKT_OFF + (16 * wave + r16) * 144 + (16 * mi + 4 * kq) * 2);
                const f32x4 bg = *(const f32x4*)(GGT + 192 + 16 * mi + 4 * kq);
                R[mi] = (f32x4){bflo(kv.x) * bg[0], bfhi(kv.x) * bg[1], bflo(kv.y) * bg[2], bfhi(kv.y) * bg[3]};
            }
            gdn_tri_solve(R, smem + GNA_OFF, smem + GXI_OFF, dir, r16, kq);
#pragma unroll
            for (int mi = 0; mi < 4; ++mi)
#pragma unroll
                for (int r = 0; r < 4; ++r) st_bf16(smem + GW_OFF + (16 * mi + 4 * kq + r) * 272 + (16 * wave + r16) * 2, R[mi][r]);
        }
        __syncthreads();
        f32x4 U[4], WS[4], QS[4];
#pragma unroll
        for (int mi = 0; mi < 4; ++mi) {
            const u32x2 vv = *(const u32x2*)(smem + GVT_OFF + (16 * wave + r16) * 144 + (16 * mi + 4 * kq) * 2);
            const f32x4 be = *(const f32x4*)(GGT + 128 + 16 * mi + 4 * kq);
            U[mi] = (f32x4){bflo(vv.x) * be[0], bfhi(vv.x) * be[1], bflo(vv.y) * be[2], bfhi(vv.y) * be[3]};
            WS[mi] = (f32x4){0.f, 0.f, 0.f, 0.f}; QS[mi] = (f32x4){0.f, 0.f, 0.f, 0.f};
        }
        gdn_tri_solve(U, smem + GNA_OFF, smem + GXI_OFF, dir, r16, kq);
#pragma unroll
        for (int ks = 0; ks < 4; ++ks)
#pragma unroll
            for (int mi = 0; mi < 4; ++mi) {
                const bf16x8 fw = ld_pair(smem + GW_OFF + (16 * mi + r16) * 272, (32 * ks + 4 * kq) * 2, (32 * ks + 16 + 4 * kq) * 2);
                const bf16x8 fq = ld_pair(smem + GQ_OFF + (16 * mi + r16) * 272, (32 * ks + 4 * kq) * 2, (32 * ks + 16 + 4 * kq) * 2);
                WS[mi] = MFMA16(fw, Sb[ks], WS[mi]); QS[mi] = MFMA16(fq, Sb[ks], QS[mi]);
            }
#pragma unroll
        for (int mi = 0; mi < 4; ++mi) U[mi] = U[mi] - WS[mi];
        {
            const bf16x8 ub0 = pack2(U[0], U[1]), ub1 = pack2(U[2], U[3]);
            f32x4 O[4];
#pragma unroll
            for (int mi = 0; mi < 4; ++mi) {
                const f32x4 gam = *(const f32x4*)(GGT + 16 * mi + 4 * kq);
                O[mi] = gam * QS[mi];
                O[mi] = MFMA16(ld_pair(smem + GP_OFF + (16 * mi + r16) * 144, (4 * kq) * 2, (16 + 4 * kq) * 2), ub0, O[mi]);
                O[mi] = MFMA16(ld_pair(smem + GP_OFF + (16 * mi + r16) * 144, (32 + 4 * kq) * 2, (48 + 4 * kq) * 2), ub1, O[mi]);
            }
            if (c >= 4) {
#pragma unroll
                for (int mi = 0; mi < 4; ++mi)
#pragma unroll
                    for (int r = 0; r < 4; ++r)
                        OG[((size_t)b * SEQ + 64 * (c - 4) + 16 * mi + 4 * kq + r) * 512 + h * 128 + 16 * wave + r16] = O[mi][r];
            }
        }
        {
            f32x4 Us[4];
#pragma unroll
            for (int mi = 0; mi < 4; ++mi) { const f32x4 dl = *(const f32x4*)(GGT + 64 + 16 * mi + 4 * kq); Us[mi] = U[mi] * dl; }
            const bf16x8 us0 = pack2(Us[0], Us[1]), us1 = pack2(Us[2], Us[3]);
            const float gl = GGT[256];
#pragma unroll
            for (int m = 0; m < 8; ++m) {
                Sacc[m] = Sacc[m] * gl;
                Sacc[m] = MFMA16(ld_pair(smem + GKT_OFF + (16 * m + r16) * 144, (4 * kq) * 2, (16 + 4 * kq) * 2), us0, Sacc[m]);
                Sacc[m] = MFMA16(ld_pair(smem + GKT_OFF + (16 * m + r16) * 144, (32 + 4 * kq) * 2, (48 + 4 * kq) * 2), us1, Sacc[m]);
            }
#pragma unroll
            for (int ks = 0; ks < 4; ++ks) Sb[ks] = pack2(Sacc[2 * ks], Sacc[2 * ks + 1]);
        }
    }
    __syncthreads();
#undef GDN_CHUNK
#undef GDN_PREFETCH
}

DI void phase_gdn_prep(const Params& p) {
    const int lane = threadIdx.x & 63, wave = threadIdx.x >> 6;
    const h16* QKV = (const h16*)(p.ws + WS_QKV);
    const float* GL = (const float*)(p.ws + WS_GL);
    h16* OUT[3] = {(h16*)(p.ws + WS_QC), (h16*)(p.ws + WS_KC), (h16*)(p.ws + WS_VC)};
    float* BETA = (float*)(p.ws + WS_BETA); float* GDEC = (float*)(p.ws + WS_GDEC);
    for (int r = blockIdx.x * 8 + wave; r < NT; r += gridDim.x * 8) {
        const int b = r / TPB, t = r % TPB;
        float acc[3][8];
#pragma unroll
        for (int s = 0; s < 3; ++s)
#pragma unroll
            for (int j = 0; j < 8; ++j) acc[s][j] = 0.f;
        if (t < CTXL) {
            for (int kx = 0; kx < 3; ++kx) {
                const int tt = t + kx - 1;
                if (tt < 0 || tt >= CTXL) continue;
                const size_t rr = (size_t)b * TPB + tt;
#pragma unroll
                for (int s = 0; s < 3; ++s) {
                    const h16x8 v = *(const h16x8*)(QKV + rr * 1536 + s * 512 + lane * 8);
                    const float* w = p.conv_w + (1 * 3 + kx) * 1536 + s * 512 + lane * 8;
#pragma unroll
                    for (int j = 0; j < 8; ++j) acc[s][j] += (float)v[j] * w[j];
                }
            }
        } else {
            const int tl = t - CTXL, gy = tl >> 6, gx = tl & 63;
            for (int ky = 0; ky < 3; ++ky) {
                const int yy = gy + ky - 1;
                if (yy < 0 || yy >= 32) continue;
                for (int kx = 0; kx < 3; ++kx) {
                    const int xx = gx + kx - 1;
                    if (xx < 0 || xx >= 64) continue;
                    const size_t rr = (size_t)b * TPB + CTXL + yy * 64 + xx;
#pragma unroll
                    for (int s = 0; s < 3; ++s) {
                        const h16x8 v = *(const h16x8*)(QKV + rr * 1536 + s * 512 + lane * 8);
                        const float* w = p.conv_w + (ky * 3 + kx) * 1536 + s * 512 + lane * 8;
#pragma unroll
                        for (int j = 0; j < 8; ++j) acc[s][j] += (float)v[j] * w[j];
                    }
                }
            }
        }
#pragma unroll
        for (int s = 0; s < 3; ++s)
#pragma unroll
            for (int j = 0; j < 8; ++j) acc[s][j] = silu_f(acc[s][j]);
#pragma unroll
        for (int s = 0; s < 2; ++s) {
            float ss = 0.f;
#pragma unroll
            for (int j = 0; j < 8; ++j) ss += acc[s][j] * acc[s][j];
            ss += __shfl_xor(ss, 1); ss += __shfl_xor(ss, 2); ss += __shfl_xor(ss, 4); ss += __shfl_xor(ss, 8);
            const float sc = rsqrtf(ss + 1e-6f) * (s == 0 ? 0.08838834764831845f : 1.0f);
#pragma unroll
            for (int j = 0; j < 8; ++j) acc[s][j] *= sc;
        }
#pragma unroll
        for (int s = 0; s < 3; ++s) {
            h16x8 o;
#pragma unroll
            for (int j = 0; j < 8; ++j) o[j] = (h16)acc[s][j];
            *(h16x8*)(OUT[s] + (size_t)r * 512 + lane * 8) = o;
        }
        if (lane < 8) {
            const float bl = GL[(size_t)r * 16 + lane], al = GL[(size_t)r * 16 + 8 + lane];
            BETA[(size_t)r * 8 + lane] = sigmoid_f(bl);
            GDEC[(size_t)r * 8 + lane] = -expf(p.a_log[lane]) * softplus_f(al + p.dt_bias[lane]);
        }
    }
}

DI int seq_row(int dir, int pos) { return dir == 0 ? pos : (pos < CTXL ? (CTXL - 1 - pos) : (TPB + CTXL - 1 - pos)); }

DI void gdn_naive_block(const Params& p, float* lds, int blk) {
    const int tid = threadIdx.x, slot = tid >> 8, half = (tid >> 7) & 1, j = tid & 127;
    const int unit = blk * 2 + slot, b = unit >> 3, h = (unit >> 1) & 3, dir = unit & 1;
    const h16* QC = (const h16*)(p.ws + WS_QC); const h16* KC = (const h16*)(p.ws + WS_KC); const h16* VC = (const h16*)(p.ws + WS_VC);
    const float* BETA = (const float*)(p.ws + WS_BETA); const float* GDEC = (const float*)(p.ws + WS_GDEC);
    float* OG = p.out + (size_t)dir * NL * 512;
    float* kq = lds + slot * (8 * 2 * 128);
    float* xk = lds + 2 * (8 * 2 * 128) + slot * 256;
    float* xo = xk + 512;
    float S[64];
#pragma unroll
    for (int i = 0; i < 64; ++i) S[i] = 0.f;
    for (int pos0 = 0; pos0 < TPB; pos0 += 8) {
#pragma unroll
        for (int e = 0; e < 8; ++e) {
            const int idx = e * 256 + (tid & 255), tok = idx >> 8, which = (idx >> 7) & 1, d = idx & 127;
            const size_t r = (size_t)b * TPB + seq_row(dir, pos0 + tok);
            kq[idx] = (float)((which ? QC : KC)[r * 512 + h * 128 + d]);
        }
        __syncthreads();
        for (int tok = 0; tok < 8; ++tok) {
            const int t = seq_row(dir, pos0 + tok);
            const size_t r = (size_t)b * TPB + t;
            const float bt = BETA[r * 8 + dir * 4 + h], a = __expf(GDEC[r * 8 + dir * 4 + h]);
            const float v = (float)VC[r * 512 + h * 128 + j];
            const float* kk = kq + tok * 256 + half * 64; const float* qq = kk + 128;
            float ks = 0.f;
#pragma unroll
            for (int i = 0; i < 64; i += 4) { const f32x4 k4 = *(const f32x4*)(kk + i); ks += k4[0] * S[i] + k4[1] * S[i + 1] + k4[2] * S[i + 2] + k4[3] * S[i + 3]; }
            xk[half * 128 + j] = ks;
            __syncthreads();
            ks += xk[(1 - half) * 128 + j];
            const float cc = bt * (v - a * ks);
            float o = 0.f;
#pragma unroll
            for (int i = 0; i < 64; i += 4) {
                const f32x4 k4 = *(const f32x4*)(kk + i), q4 = *(const f32x4*)(qq + i);
                S[i] = a * S[i] + k4[0] * cc; S[i + 1] = a * S[i + 1] + k4[1] * cc; S[i + 2] = a * S[i + 2] + k4[2] * cc; S[i + 3] = a * S[i + 3] + k4[3] * cc;
                o += q4[0] * S[i] + q4[1] * S[i + 1] + q4[2] * S[i + 2] + q4[3] * S[i + 3];
            }
            xo[half * 128 + j] = o;
            __syncthreads();
            if (half == 0 && t >= CTXL) OG[((size_t)b * SEQ + (t - CTXL)) * 512 + h * 128 + j] = o + xo[128 + j];
        }
        __syncthreads();
    }
}

DI void s5_naive_wave(const Params& p, float* ubuf  , int u) {
    const int lane = threadIdx.x & 63, b = u >> 5, g = u & 31, pidx = lane;
    const h16* UG = (const h16*)(p.ws + WS_UG) + ((size_t)b * 32 + g) * TPB * 16;
    float* YS5 = (float*)(p.ws + WS_YS5); h16* G = (h16*)(p.ws + WS_G);
    for (int dir = 0; dir < 2; ++dir) {
        const int dg = dir * 32 + g;
        const double lre = p.lre[dg * 64 + pidx], lim = p.lim[dg * 64 + pidx], dt = (double)expf(p.logdt[dg]);
        double ang = lim * dt; ang -= 6.283185307179586477 * rint(ang * 0.15915494309189533577);
        float sn, cs; sincosf((float)ang, &sn, &cs);
        const double er = (double)expf((float)(lre * dt)), ar_d = er * (double)cs, ai_d = er * (double)sn;
        const double nr = ar_d - 1.0, ni = ai_d, den = lre * lre + lim * lim;
        const float cfr = (float)((nr * lre + ni * lim) / den), cfi = (float)((ni * lre - nr * lim) / den);
        const float ar = (float)ar_d, ai = (float)ai_d;
        float bbr[16], bbi[16], ccr[16], cci[16];
#pragma unroll
        for (int c = 0; c < 16; ++c) {
            const float br = p.bre[((size_t)dg * 64 + pidx) * 16 + c], bi = p.bim[((size_t)dg * 64 + pidx) * 16 + c];
            bbr[c] = cfr * br - cfi * bi; bbi[c] = cfr * bi + cfi * br;
            ccr[c] = p.cre[((size_t)dg * 16 + c) * 64 + pidx]; cci[c] = p.cim[((size_t)dg * 16 + c) * 64 + pidx];
        }
        float hr = 0.f, hi = 0.f;
        for (int pos0 = 0; pos0 < TPB; pos0 += 64) {
            {
                const int t = seq_row(dir, pos0 + lane);
                const h16x8 v0 = *(const h16x8*)(UG + (size_t)t * 16), v1 = *(const h16x8*)(UG + (size_t)t * 16 + 8);
#pragma unroll
                for (int c = 0; c < 8; ++c) { ubuf[lane * 16 + c] = (float)v0[c]; ubuf[lane * 16 + 8 + c] = (float)v1[c]; }
            }
            asm volatile("s_waitcnt lgkmcnt(0)" ::: "memory");
            for (int tk = 0; tk < 64; ++tk) {
                const int t = seq_row(dir, pos0 + tk);
                float uu[16];
#pragma unroll
                for (int c = 0; c < 16; c += 4) { const f32x4 q = *(const f32x4*)(ubuf + tk * 16 + c); uu[c] = q[0]; uu[c + 1] = q[1]; uu[c + 2] = q[2]; uu[c + 3] = q[3]; }
                float sr = 0.f, si = 0.f;
#pragma unroll
                for (int c = 0; c < 16; ++c) { sr += bbr[c] * uu[c]; si += bbi[c] * uu[c]; }
                const float nhr = ar * hr - ai * hi + sr, nhi = ar * hi + ai * hr + si;
                hr = nhr; hi = nhi;
                if (t >= CTXL) {
                    float v[16];
#pragma unroll
                    for (int c = 0; c < 16; ++c) v[c] = ccr[c] * hr - cci[c] * hi;
                    const bool b5 = (lane >> 5) & 1, b4 = (lane >> 4) & 1, b3 = (lane >> 3) & 1, b2 = (lane >> 2) & 1;
                    float w8[8], w4[4], w2[2], w1;
#pragma unroll
                    for (int i = 0; i < 8; ++i) { const float keep = b5 ? v[8 + i] : v[i], send = b5 ? v[i] : v[8 + i]; w8[i] = keep + __shfl_xor(send, 32); }
#pragma unroll
                    for (int i = 0; i < 4; ++i) { const float keep = b4 ? w8[4 + i] : w8[i], send = b4 ? w8[i] : w8[4 + i]; w4[i] = keep + __shfl_xor(send, 16); }
#pragma unroll
                    for (int i = 0; i < 2; ++i) { const float keep = b3 ? w4[2 + i] : w4[i], send = b3 ? w4[i] : w4[2 + i]; w2[i] = keep + __shfl_xor(send, 8); }
                    { const float keep = b2 ? w2[1] : w2[0], send = b2 ? w2[0] : w2[1]; w1 = keep + __shfl_xor(send, 4); }
                    w1 += __shfl_xor(w1, 2); w1 += __shfl_xor(w1, 1);
                    if ((lane & 3) == 0) {
                        const int c = lane >> 2;
                        const size_t o = ((size_t)b * SEQ + (t - CTXL)) * 512 + g * 16 + c;
                        if (dir == 0) YS5[o] = p.s5d[g * 16 + c] * ubuf[tk * 16 + c] + w1;
                        else G[o] = (h16)gelu_f(YS5[o] + w1);
                    }
                }
            }
            asm volatile("s_waitcnt lgkmcnt(0)" ::: "memory");
        }
    }
}

DI void phase_seq(const Params& p, float* lds) {
#if GDN_NAIVE
    if ((int)blockIdx.x < 64) { gdn_naive_block(p, lds, blockIdx.x); return; }
    for (int u = (int)blockIdx.x - 64; u < 512; u += (int)gridDim.x - 64) s5_unit(p, (unsigned char*)lds, u);
#else
    if ((int)blockIdx.x < 128) { gdn_unit(p, (unsigned char*)lds, blockIdx.x); if (DUP_SUB == 1) gdn_unit(p, (unsigned char*)lds, blockIdx.x); return; }
    for (int rep = 0; rep < (DUP_SUB == 2 ? 2 : 1); ++rep)
    for (int u = (int)blockIdx.x - 128; u < 512; u += (int)gridDim.x - 128) s5_unit(p, (unsigned char*)lds, u);
#endif
}

DI void phase_mix(const Params& p, PG8_LAS unsigned char* ldsp) {
    {
        pg8::Gemm g{(const bf16_t*)(p.ws + WS_G), (const bf16_t*)(p.ws + WS_WGLUT), NL, 512, 512};
        pg8::StaticOrder S; S.init(NL, 512, (int)gridDim.x, (int)blockIdx.x);
        EpiGluMK E{(const bf16_t*)(p.ws + WS_G), (const bf16_t*)(p.ws + WS_ZS), p.b_glu, (bf16_t*)(p.ws + WS_MIX)};
        pg8::gemm_phase(ldsp, g, S, E);
    }
    const int lane = threadIdx.x & 63, wave = threadIdx.x >> 6;
    const float* OGF = p.out; const float* OGR = p.out + (size_t)NL * 512;
    const h16* ZG = (const h16*)(p.ws + WS_ZG); h16* MIX = (h16*)(p.ws + WS_MIX);
    for (int r = blockIdx.x * 8 + wave; r < NL; r += gridDim.x * 8) {
        const int b = r / SEQ, tl = r % SEQ; const size_t rnt = (size_t)b * TPB + CTXL + tl;
        float o[8]; float ss = 0.f;
#pragma unroll
        for (int j = 0; j < 8; ++j) { o[j] = OGF[(size_t)r * 512 + lane * 8 + j] + OGR[(size_t)r * 512 + lane * 8 + j]; ss += o[j] * o[j]; }
        ss += __shfl_xor(ss, 1); ss += __shfl_xor(ss, 2); ss += __shfl_xor(ss, 4); ss += __shfl_xor(ss, 8);
        const float rs = rsqrtf(ss * (1.f / 128.f) + 1e-6f);
        const h16x8 z = *(const h16x8*)(ZG + rnt * 512 + lane * 8);
        h16x8 ov;
#pragma unroll
        for (int j = 0; j < 8; ++j) ov[j] = (h16)(o[j] * rs * p.norm_w[(lane * 8 + j) & 127] * silu_f((float)z[j]));
        *(h16x8*)(MIX + (size_t)r * 1024 + 512 + lane * 8) = ov;
    }
}

DI void phase_out(const Params& p, PG8_LAS unsigned char* ldsp) {
    pg8::Gemm g{(const bf16_t*)(p.ws + WS_MIX), (const bf16_t*)(p.ws + WS_WOUTT), NL, 1024, 1024};
    pg8::StaticOrder S; S.init(NL, 1024, (int)gridDim.x, (int)blockIdx.x);
    pg8::EpiF32 E{(float*)(p.ws + WS_Y), 1024, nullptr};
    pg8::gemm_phase(ldsp, g, S, E);
}
DI void phase_inproj(const Params& p, PG8_LAS unsigned char* ldsp) {
    pg8::Gemm g{(const bf16_t*)(p.ws + WS_HB), (const bf16_t*)(p.ws + WS_WINT), NT, NIN_PAD, DM};
    pg8::StaticOrder S; S.init(NT, NIN_PAD, (int)gridDim.x, (int)blockIdx.x);
    EpiInprojMK E{(bf16_t*)(p.ws + WS_UG), (bf16_t*)(p.ws + WS_ZS), (bf16_t*)(p.ws + WS_QKV), (bf16_t*)(p.ws + WS_ZG), (float*)(p.ws + WS_GL)};
    pg8::gemm_phase(ldsp, g, S, E);
}

DI void phase_ln(const Params& p) {
    const int lane = threadIdx.x & 63, wave = threadIdx.x >> 6;
    const float* ADA = (const float*)(p.ws + WS_ADA); const float* Y = (const float*)(p.ws + WS_Y);
    for (int r = blockIdx.x * 8 + wave; r < NL; r += gridDim.x * 8) {
        const int b = r / SEQ;
        f32x4 v[4]; float s = 0.f;
#pragma unroll
        for (int j = 0; j < 4; ++j) {
            const int k = j * 256 + lane * 4;
            const f32x4 xv = *(const f32x4*)(p.x + (size_t)r * DM + k), yv = *(const f32x4*)(Y + (size_t)r * DM + k), gt = *(const f32x4*)(ADA + b * 3072 + 2048 + k);
            v[j] = xv * DN_ALPHA + gt * yv;
            s += (v[j][0] + v[j][1]) + (v[j][2] + v[j][3]);
        }
#pragma unroll
        for (int o = 1; o < 64; o <<= 1) s += __shfl_xor(s, o);
        const float mean = s * (1.f / DM); float q = 0.f;
#pragma unroll
        for (int j = 0; j < 4; ++j) { v[j] = v[j] - mean; q += (v[j][0] * v[j][0] + v[j][1] * v[j][1]) + (v[j][2] * v[j][2] + v[j][3] * v[j][3]); }
#pragma unroll
        for (int o = 1; o < 64; o <<= 1) q += __shfl_xor(q, o);
        const float rstd = rsqrtf(q * (1.f / DM) + 1e-5f);
#pragma unroll
        for (int j = 0; j < 4; ++j) {
            const int k = j * 256 + lane * 4;
            const f32x4 gg = *(const f32x4*)(p.ln_g + k), bb = *(const f32x4*)(p.ln_b + k);
            *(f32x4*)(p.out + (size_t)r * DM + k) = v[j] * rstd * gg + bb;
        }
    }
}


#define LAS __attribute__((address_space(3)))
#define XB_TMO      128
#define XB_XCNT(j)  (256  + 64 * (j))
#define XB_XSUB(j)  (1280 + 64 * (j))
#define XB_XGEN(j)  (2304 + 64 * (j))
#define XB_TOP      3328
#define XB_TOPGEN   3392
#define XCD_BAR_WORDS 3456
#define XB_SPIN_CAP (1u << 18)

__device__ __forceinline__ unsigned xb_ld(unsigned* p)              { return __hip_atomic_load(p, __ATOMIC_RELAXED, __HIP_MEMORY_SCOPE_AGENT); }
__device__ __forceinline__ unsigned xb_add(unsigned* p, unsigned v) { return __hip_atomic_fetch_add(p, v, __ATOMIC_RELAXED, __HIP_MEMORY_SCOPE_AGENT); }
__device__ __forceinline__ unsigned xb_xcc_id() { return (unsigned)__builtin_amdgcn_s_getreg((3 << 11) | 20) & 0xFu; }
#define XB_SPIN(cond, bar) do { unsigned _sp = 0; while (cond) { __builtin_amdgcn_s_sleep(1); \
    if ((++_sp & 255u) == 0u) { if (xb_ld(&(bar)[XB_TMO])) break; if (_sp > XB_SPIN_CAP) { atomicAdd(&(bar)[XB_TMO], 1u); break; } } } } while (0)

struct XcdBarrier {
    unsigned* bar; unsigned x;
    volatile LAS unsigned* st;
};

__device__ __forceinline__ XcdBarrier xcd_barrier_post(unsigned* bar, volatile LAS unsigned* st) {
    XcdBarrier b; b.bar = bar; b.x = xb_xcc_id(); b.st = st;
    if (threadIdx.x == 0) (void)xb_add(&bar[XB_XCNT(b.x)], 1u);
    return b;
}
__device__ __forceinline__ void xcd_barrier_complete(unsigned* bar, unsigned x, unsigned& nloc, unsigned& nx) {
    const unsigned G = gridDim.x * gridDim.y * gridDim.z;
    unsigned sum, cnt, mine, sp = 0u;
    for (;;) {
        sum = 0u; cnt = 0u; mine = 0u;
#pragma unroll
        for (unsigned j = 0; j < 16; ++j) { const unsigned c = xb_ld(&bar[XB_XCNT(j)]); sum += c; cnt += (c > 0u) ? 1u : 0u; mine = (j == x) ? c : mine; }
        if (sum == G) break;
        __builtin_amdgcn_s_sleep(1);
        if ((++sp & 255u) == 0u) { if (xb_ld(&bar[XB_TMO])) break; if (sp > XB_SPIN_CAP) { atomicAdd(&bar[XB_TMO], 1u); break; } }
    }
    nloc = mine > 0u ? mine : 1u; nx = cnt > 0u ? cnt : 1u;
}

__device__ __forceinline__ void xcd_barrier(const XcdBarrier& b) {
    asm volatile("s_waitcnt vmcnt(0)" ::: "memory");
    __syncthreads();
    if (threadIdx.x == 0) {
        unsigned* bar = b.bar;
        __builtin_amdgcn_s_waitcnt(0);
        unsigned nloc = b.st[0], nx = b.st[1];
        if (nloc == 0u) { xcd_barrier_complete(bar, b.x, nloc, nx); b.st[0] = nloc; b.st[1] = nx; }
        const unsigned old = xb_add(&bar[XB_XSUB(b.x)], 1u);
        const unsigned gen = old / nloc;
        if (old + 1u == (gen + 1u) * nloc) {
            __builtin_amdgcn_fence(__ATOMIC_RELEASE, "agent");
            asm volatile("s_waitcnt vmcnt(0)" ::: "memory");
            const unsigned og = xb_add(&bar[XB_TOP], 1u);
            const unsigned tg = og / nx;
            if (og + 1u == (tg + 1u) * nx) xb_add(&bar[XB_TOPGEN], 1u);
            else XB_SPIN(xb_ld(&bar[XB_TOPGEN]) == tg, bar);
            __builtin_amdgcn_fence(__ATOMIC_ACQUIRE, "agent");
            xb_add(&bar[XB_XGEN(b.x)], 1u);
            asm volatile("s_waitcnt vmcnt(0)" ::: "memory");
        } else {
            XB_SPIN(xb_ld(&bar[XB_XGEN(b.x)]) == gen, bar);
            __builtin_amdgcn_fence(__ATOMIC_ACQUIRE, "agent");
            asm volatile("s_waitcnt vmcnt(0)" ::: "memory");
        }
    }
    __syncthreads();
}


constexpr int NPHASE = 9;
constexpr int LDS_BYTES = 163840;

#if defined(__HIP_DEVICE_COMPILE__)
typedef const __attribute__((address_space(4))) Params* KParamsPtr;
DI Params load_params() { KParamsPtr kp = (KParamsPtr)__builtin_amdgcn_kernarg_segment_ptr(); asm volatile("" : "+s"(kp)); Params q; __builtin_memcpy(&q, kp, sizeof(Params)); return q; }
#else
DI Params load_params() { return Params{}; }
#endif

template <bool COOP>
__global__ void __launch_bounds__(NTHR, 2) mega(Params p_unused, int ph_lo, int ph_hi) {
    extern __shared__ __attribute__((aligned(16))) unsigned char smem[];
    float* lds = (float*)smem;
    PG8_LAS unsigned char* ldsp = (PG8_LAS unsigned char*)smem;
    XcdBarrier xbar; xbar.bar = nullptr; xbar.x = 0; xbar.st = nullptr;
    if (COOP) {
        volatile LAS unsigned* misc = (volatile LAS unsigned*)(ldsp + (LDS_BYTES - 64));
        if (threadIdx.x < 4) misc[threadIdx.x] = 0u;
        __syncthreads();
        unsigned* barw = (unsigned*)(load_params().ws + WS_CTL);
        xbar = xcd_barrier_post(barw, misc);
    }
#ifndef ONLY_PHASE
#define ONLY_PHASE -1
#endif
#define PH_IN(k) (ph_lo <= (k) && (k) < ph_hi && (ONLY_PHASE < 0 || ONLY_PHASE == (k)))
#define PH_SYNC(k) do { if (COOP && PH_IN(k) && PH_IN((k) + 1)) { if ((k) == 0) cg::this_grid().sync(); else xcd_barrier(xbar); } } while (0)
    if (PH_IN(0)) { const Params p = load_params(); phase_ada(p, lds); if ((int)blockIdx.x >= 48 && (int)blockIdx.x < 80) s5_build_tables(p, lds, (int)blockIdx.x - 48); __syncthreads(); phase_weights(p, lds); if (DUP_PHASE == 0) { if (COOP) cg::this_grid().sync(); __syncthreads(); phase_ada(p, lds); if ((int)blockIdx.x >= 48 && (int)blockIdx.x < 80) s5_build_tables(p, lds, (int)blockIdx.x - 48); __syncthreads(); phase_weights(p, lds); } }
    PH_SYNC(0);
    if (PH_IN(1)) { const Params p = load_params(); phase_modulate(p); if (DUP_PHASE == 1) { if (COOP) cg::this_grid().sync(); __syncthreads(); phase_modulate(p); } }
    PH_SYNC(1);
    if (PH_IN(2)) { const Params p = load_params(); phase_inproj(p, ldsp); if (DUP_PHASE == 2) { if (COOP) cg::this_grid().sync(); __syncthreads(); phase_inproj(p, ldsp); } }
    PH_SYNC(2);
    if (PH_IN(3)) { const Params p = load_params(); phase_gdn_prep(p); if (DUP_PHASE == 3) { if (COOP) cg::this_grid().sync(); phase_gdn_prep(p); } }
    PH_SYNC(3);
    if (PH_IN(4)) { const Params p = load_params(); phase_gdn_local(p, smem); if (DUP_PHASE == 4) { if (COOP) cg::this_grid().sync(); __syncthreads(); phase_gdn_local(p, smem); } }
    PH_SYNC(4);
    if (PH_IN(5)) { const Params p = load_params(); phase_seq(p, lds); if (DUP_PHASE == 5) { if (COOP) cg::this_grid().sync(); __syncthreads(); phase_seq(p, lds); } }
    PH_SYNC(5);
    if (PH_IN(6)) { const Params p = load_params(); phase_mix(p, ldsp); if (DUP_PHASE == 6) { if (COOP) cg::this_grid().sync(); __syncthreads(); phase_mix(p, ldsp); } }
    PH_SYNC(6);
    if (PH_IN(7)) { const Params p = load_params(); phase_out(p, ldsp); if (DUP_PHASE == 7) { if (COOP) cg::this_grid().sync(); __syncthreads(); phase_out(p, ldsp); } }
    PH_SYNC(7);
    if (PH_IN(8)) { const Params p = load_params(); phase_ln(p); if (DUP_PHASE == 8) { if (COOP) cg::this_grid().sync(); phase_ln(p); } }
}

extern "C" void kernel_launch(void* const* d_in, const int* in_sizes, int n_in, void* d_out, int out_size, void* d_ws, size_t ws_size,
                              hipStream_t stream) {
    static int grid = 0;
    if (grid == 0) {
        if (n_in != 24 || ws_size < WS_END) { fprintf(stderr, "kernel_launch: unexpected n_in %d / ws_size %zu\n", n_in, ws_size); grid = -1; return; }
        int dev = 0, cus = 0;
        hipGetDevice(&dev);
        hipDeviceGetAttribute(&cus, hipDeviceAttributeMultiprocessorCount, dev);
        hipFuncSetAttribute((const void*)mega<true>, hipFuncAttributeMaxDynamicSharedMemorySize, LDS_BYTES);
        hipFuncSetAttribute((const void*)mega<false>, hipFuncAttributeMaxDynamicSharedMemorySize, LDS_BYTES);
        int per_cu = 0;
        hipOccupancyMaxActiveBlocksPerMultiprocessor(&per_cu, (const void*)mega<true>, NTHR, LDS_BYTES);
        if (per_cu < 1) fprintf(stderr, "kernel_launch: occupancy query says %d blocks/CU\n", per_cu);
        (void)hipGetLastError();
        grid = cus > 0 ? cus : 256;
    }
    if (grid < 0) return;
    Params p{};
    const float** pp = (const float**)&p;
    for (int i = 0; i < 24; ++i) pp[i] = (const float*)d_in[i];
    p.out = (float*)d_out; p.ws = (unsigned char*)d_ws;
#if MK_ONE_LAUNCH
    if (hipMemsetAsync((char*)d_ws + WS_CTL, 0, XCD_BAR_WORDS * 4, stream) != hipSuccess) { fprintf(stderr, "kernel_launch: memset failed\n"); return; }
    int lo = 0, hi = NPHASE;
    void* args[] = {&p, &lo, &hi};
    hipError_t e = hipLaunchCooperativeKernel((const void*)mega<true>, dim3(grid), dim3(NTHR), args, LDS_BYTES, stream);
    if (e != hipSuccess) fprintf(stderr, "cooperative launch failed: %s (grid %d)\n", hipGetErrorString(e), grid);
#else
    for (int ph = 0; ph < NPHASE; ++ph) hipLaunchKernelGGL(mega<false>, dim3(grid), dim3(NTHR), LDS_BYTES, stream, p, ph, ph + 1);
#endif
}
```
